# Optimizing an MI355X kernel written in HIP

```python
import jax, jax.numpy as jnp
from jax import lax
import numpy as np

D_MODEL = 1024
BATCH = 8
SEQ = 2048
DEPTH = 1
DEC_BATCH = 128
DEC_SEQ = 1
PAST_LEN = 16384
PAGE_SIZE = 128

HG_HEADS = 8
HG_DK = 128
HG_DV = D_MODEL // HG_HEADS
HG_KW = HG_HEADS * HG_DK
HG_VW = HG_HEADS * HG_DV
HG_CHUNK = 16
LRU_W = D_MODEL
LRU_BLOCKS = 8
LRU_BW = LRU_W // LRU_BLOCKS
CONV_W = 4
LRU_C = 8.0
D_FF = ((-(-8 * D_MODEL // 3) + 255) // 256) * 256
EPS = 1e-6
_SIZES = (HG_KW, HG_KW, HG_VW, HG_VW, LRU_W, LRU_W, D_MODEL, D_MODEL)
N_IN = sum(_SIZES)

kernel_name = "hgrn2_rglru_gated_parallel_decoder_step"


def _rmsnorm(x, g):
    xf = x.astype(jnp.float32)
    y = xf * lax.rsqrt(jnp.mean(xf * xf, axis=-1, keepdims=True) + EPS) * g.astype(jnp.float32)
    return y.astype(x.dtype)


def _gla_chunk_step(S, xs):
    qc, kc, vc, bc = xs
    C = qc.shape[1]
    causal = jnp.tril(jnp.ones((C, C), bool))[None, :, :, None, None]
    diff = bc[:, :, None] - bc[:, None, :]
    decay = jnp.exp(jnp.where(causal, diff, -jnp.inf))
    scores = jnp.einsum('bthk,bshk,btshk->btsh', qc, kc, decay)
    o = (jnp.einsum('bthk,bhkv->bthv', qc * jnp.exp(bc), S)
         + jnp.einsum('btsh,bshv->bthv', scores, vc))
    b_last = bc[:, -1]
    S_new = (jnp.exp(b_last)[..., None] * S
             + jnp.einsum('bshk,bshv->bhkv', kc * jnp.exp(b_last[:, None] - bc), vc))
    return S_new, o


def _hgrn2(q, k, v, logf, S0, chunk):
    B, T, H, K = q.shape
    V = v.shape[-1]
    n = T // chunk

    def blocks(a):
        return jnp.moveaxis(a.reshape(B, n, chunk, H, a.shape[-1]), 1, 0)

    bc = jnp.cumsum(blocks(logf), axis=2)
    S_last, o = lax.scan(_gla_chunk_step, S0, (blocks(q), blocks(k), blocks(v), bc))
    return jnp.moveaxis(o, 0, 1).reshape(B, T, H, V), S_last


def _causal_conv(x, buf, w, b):
    T = x.shape[1]
    xp = jnp.concatenate([buf.astype(x.dtype), x], axis=1)
    y = b
    for j in range(CONV_W):
        y = y + xp[:, j:j + T] * w[j]
    return y, xp[:, -(CONV_W - 1):]


def _lru_combine(l, r):
    return (l[0] * r[0], r[0] * l[1] + r[1])


def _rglru(xc, ra, ix, log_lambda, h0, fresh):
    log_a = -LRU_C * jax.nn.sigmoid(ra) * jax.nn.softplus(-log_lambda)
    a = jnp.exp(log_a)
    mult = jnp.sqrt(-jnp.expm1(2.0 * log_a))
    if fresh:
        mult = mult.at[:, 0].set(1.0)
    b = mult * (jax.nn.sigmoid(ix) * xc)
    b = b.at[:, 0].add(a[:, 0] * h0)
    _, h = lax.associative_scan(_lru_combine, (a, b), axis=1)
    return h, h[:, -1]


def _layer(x, S0, h0, cbuf, fresh, chunk, lb,
           n_mix_pre, n_mix_post, n_ffn_pre, n_ffn_post, w_in, hg_onorm,
           conv_w, conv_b, wa, ba, wx, bx, log_lambda, w_pa, w_pb, w_o, w_fi, w_fo):
    B, T, _ = x.shape
    f32 = jnp.float32
    xn = _rmsnorm(x, n_mix_pre)
    proj = xn @ w_in
    idx = [int(s) for s in np.cumsum(_SIZES)[:-1]]
    q, fp, iv, og, lx, ly, ga, gb = jnp.split(proj, idx, axis=-1)

    lbh = lb.reshape(HG_HEADS, HG_DK)
    f = lbh + (1.0 - lbh) * jax.nn.sigmoid(fp.astype(f32).reshape(B, T, HG_HEADS, HG_DK))
    logf = jnp.log(f)
    kk = 1.0 - f
    qh = jax.nn.silu(q.astype(f32)).reshape(B, T, HG_HEADS, HG_DK)
    vh = iv.astype(f32).reshape(B, T, HG_HEADS, HG_DV)
    o, S_new = _hgrn2(qh, kk, vh, logf, S0.astype(f32), chunk)
    o = o * lax.rsqrt(jnp.mean(o * o, axis=-1, keepdims=True) + EPS) * hg_onorm.astype(f32)
    o = o * jax.nn.silu(og.astype(f32).reshape(B, T, HG_HEADS, HG_DV))
    out_a = o.reshape(B, T, HG_VW).astype(x.dtype) @ w_pa

    xc, cbuf_new = _causal_conv(lx, cbuf, conv_w, conv_b)
    xb = xc.reshape(B, T, LRU_BLOCKS, LRU_BW)
    ra = (jnp.einsum('btnc,ncd->btnd', xb, wa) + ba).reshape(B, T, LRU_W).astype(f32)
    ix = (jnp.einsum('btnc,ncd->btnd', xb, wx) + bx).reshape(B, T, LRU_W).astype(f32)
    h, h_last = _rglru(xc.astype(f32), ra, ix, log_lambda.astype(f32), h0.astype(f32), fresh)
    out_b = (jax.nn.gelu(ly) * h.astype(x.dtype)) @ w_pb

    merged = jax.nn.sigmoid(ga) * out_a + jax.nn.sigmoid(gb) * out_b
    x = x + _rmsnorm(merged @ w_o, n_mix_post)

    hn = _rmsnorm(x, n_ffn_pre)
    gate, up = jnp.split(hn @ w_fi, 2, axis=-1)
    x = x + _rmsnorm((jax.nn.silu(gate) * up) @ w_fo, n_ffn_post)
    return x, S_new.astype(S0.dtype), h_last.astype(h0.dtype), cbuf_new.astype(cbuf.dtype)


def setup_inputs(seed: int = 0) -> dict:
    key = jax.random.key(seed)
    ks = jax.random.split(key, 32)
    f32 = jnp.float32

    def nrm(k, shape, scale):
        return jax.random.normal(k, shape, f32) * scale

    def gain(k, shape):
        return 1.0 + 0.05 * jax.random.normal(k, shape, f32)

    a_c = jax.random.uniform(ks[20], (DEPTH, LRU_W), f32, 0.9, 0.999)
    s = a_c ** (1.0 / LRU_C)
    log_lambda = jnp.log(s) - jnp.log1p(-s)
    return {
        "x_prompt": nrm(ks[0], (BATCH, SEQ, D_MODEL), 1.0),
        "x_sample": nrm(ks[1], (DEC_BATCH, DEC_SEQ, D_MODEL), 1.0),
        "state_hgrn": nrm(ks[2], (DEPTH, DEC_BATCH, HG_HEADS, HG_DK, HG_DV), 0.3),
        "state_lru": nrm(ks[3], (DEPTH, DEC_BATCH, LRU_W), 0.5),
        "state_conv": nrm(ks[4], (DEPTH, DEC_BATCH, CONV_W - 1, LRU_W), 1.0),
        "norm_mix_pre": gain(ks[5], (DEPTH, D_MODEL)),
        "norm_mix_post": gain(ks[6], (DEPTH, D_MODEL)),
        "norm_ffn_pre": gain(ks[7], (DEPTH, D_MODEL)),
        "norm_ffn_post": gain(ks[8], (DEPTH, D_MODEL)),
        "w_in": nrm(ks[9], (DEPTH, D_MODEL, N_IN), D_MODEL ** -0.5),
        "hg_lb_logits": nrm(ks[10], (DEPTH + 1, HG_KW), 0.5),
        "hg_out_norm": gain(ks[11], (DEPTH, HG_DV)),
        "lru_conv_w": nrm(ks[12], (DEPTH, CONV_W, LRU_W), CONV_W ** -0.5),
        "lru_conv_b": nrm(ks[13], (DEPTH, LRU_W), 0.02),
        "lru_w_a": nrm(ks[14], (DEPTH, LRU_BLOCKS, LRU_BW, LRU_BW), LRU_BW ** -0.5),
        "lru_b_a": nrm(ks[15], (DEPTH, LRU_BLOCKS, LRU_BW), 0.1),
        "lru_w_x": nrm(ks[16], (DEPTH, LRU_BLOCKS, LRU_BW, LRU_BW), LRU_BW ** -0.5),
        "lru_b_x": nrm(ks[17], (DEPTH, LRU_BLOCKS, LRU_BW), 0.1),
        "lru_log_lambda": log_lambda,
        "w_branch_a": nrm(ks[18], (DEPTH, HG_VW, D_MODEL), HG_VW ** -0.5),
        "w_branch_b": nrm(ks[19], (DEPTH, LRU_W, D_MODEL), LRU_W ** -0.5),
        "w_out": nrm(ks[21], (DEPTH, D_MODEL, D_MODEL), D_MODEL ** -0.5),
        "w_ffn_in": nrm(ks[22], (DEPTH, D_MODEL, 2 * D_FF), D_MODEL ** -0.5),
        "w_ffn_out": nrm(ks[23], (DEPTH, D_FF, D_MODEL), D_FF ** -0.5),
    }


def reference(x_prompt, x_sample, state_hgrn, state_lru, state_conv,
              norm_mix_pre, norm_mix_post, norm_ffn_pre, norm_ffn_post, w_in,
              hg_lb_logits, hg_out_norm, lru_conv_w, lru_conv_b, lru_w_a, lru_b_a,
              lru_w_x, lru_b_x, lru_log_lambda, w_branch_a, w_branch_b, w_out,
              w_ffn_in, w_ffn_out):
    lb_all = jnp.cumsum(jax.nn.softmax(hg_lb_logits.astype(jnp.float32), axis=0), axis=0)
    yp, ys = x_prompt, x_sample
    hg_p, lru_p, cv_p, hg_s, lru_s, cv_s = [], [], [], [], [], []
    for l in range(DEPTH):
        lp = (norm_mix_pre[l], norm_mix_post[l], norm_ffn_pre[l], norm_ffn_post[l], w_in[l],
              hg_out_norm[l], lru_conv_w[l], lru_conv_b[l], lru_w_a[l], lru_b_a[l],
              lru_w_x[l], lru_b_x[l], lru_log_lambda[l], w_branch_a[l], w_branch_b[l],
              w_out[l], w_ffn_in[l], w_ffn_out[l])
        S0p = jnp.zeros((BATCH, HG_HEADS, HG_DK, HG_DV), state_hgrn.dtype)
        h0p = jnp.zeros((BATCH, LRU_W), state_lru.dtype)
        c0p = jnp.zeros((BATCH, CONV_W - 1, LRU_W), state_conv.dtype)
        yp, a1, a2, a3 = _layer(yp, S0p, h0p, c0p, True, HG_CHUNK, lb_all[l], *lp)
        ys, b1, b2, b3 = _layer(ys, state_hgrn[l], state_lru[l], state_conv[l], False,
                                ys.shape[1], lb_all[l], *lp)
        hg_p.append(a1); lru_p.append(a2); cv_p.append(a3)
        hg_s.append(b1); lru_s.append(b2); cv_s.append(b3)
    return (yp, ys, jnp.stack(hg_p), jnp.stack(lru_p), jnp.stack(cv_p),
            jnp.stack(hg_s), jnp.stack(lru_s), jnp.stack(cv_s))
```

```cpp
#include <hip/hip_runtime.h>
#include <hip/hip_cooperative_groups.h>
#include <cstdio>
namespace cg = cooperative_groups;

#define LAS __attribute__((address_space(3)))
typedef unsigned short bf16_t;
typedef short bf16x8 __attribute__((ext_vector_type(8)));
typedef short s16x4 __attribute__((ext_vector_type(4)));
typedef float f32x4 __attribute__((ext_vector_type(4)));
typedef float f32x2 __attribute__((ext_vector_type(2)));
typedef unsigned u32x4 __attribute__((ext_vector_type(4)));
typedef unsigned u32x2 __attribute__((ext_vector_type(2)));
#define DI __device__ __forceinline__

constexpr int MP = 16384, MS = 128, MR = MP + MS, MT = 16640;
constexpr int DM = 1024, TSEQ = 2048, NBATCH = 8, DFF = 2816, NFI = 5632;
constexpr float EPS = 1e-6f;
constexpr int NTHREADS = 512;

constexpr size_t O_Y = 0, O_HGP = 16908288, O_LRUP = 17956864, O_CVP = 17965056, O_HGS = 17989632, O_LRUS = 34766848, O_CVS = 34897920;
constexpr size_t SEGB = (size_t)MT * 1024 * 2;
constexpr size_t WS_WIN = 0;
constexpr size_t WS_WPA = WS_WIN + (size_t)8192 * 1024 * 2;
constexpr size_t WS_WPB = WS_WPA + (size_t)1024 * 1024 * 2;
constexpr size_t WS_WO  = WS_WPB + (size_t)1024 * 1024 * 2;
constexpr size_t WS_WFI = WS_WO + (size_t)1024 * 1024 * 2;
constexpr size_t WS_WFO = WS_WFI + (size_t)NFI * 1024 * 2;
constexpr size_t WS_WLA = WS_WFO + (size_t)1024 * DFF * 2;
constexpr size_t WS_WLX = WS_WLA + (size_t)8 * 128 * 128 * 2;
constexpr size_t WS_SEG = WS_WLX + (size_t)8 * 128 * 128 * 2;
constexpr size_t WS_AIN = WS_SEG + 4 * SEGB;
constexpr size_t WS_BIN = WS_AIN + SEGB;
constexpr size_t WS_END = WS_BIN + SEGB;
static_assert(WS_END <= (size_t)256 * 1024 * 1024, "workspace");

struct Params { const float* in[24]; float* out; unsigned char* ws; int ph_lo, ph_hi; };

DI unsigned f2bf(float f) { unsigned u = __builtin_bit_cast(unsigned, f); return (u + 0x7fffu + ((u >> 16) & 1u)) >> 16; }
DI unsigned pk2(float lo, float hi) { return f2bf(lo) | (f2bf(hi) << 16); }
DI float bf2f(unsigned short b) { return __builtin_bit_cast(float, ((unsigned)b) << 16); }
DI float bflo(unsigned w) { return __builtin_bit_cast(float, w << 16); }
DI float bfhi(unsigned w) { return __builtin_bit_cast(float, w & 0xffff0000u); }
DI float fexp(float x) { return __expf(x); }
DI float frcp(float x) { return __builtin_amdgcn_rcpf(x); }
DI float sigm(float x) { return frcp(1.0f + fexp(-x)); }
DI float silu(float x) { return x * sigm(x); }
DI float gelu_tanh(float x) { const float u = 1.5957691216f * (x + 0.044715f * x * x * x); return x * sigm(u); }
DI float wave_sum(float v) {
#pragma unroll
    for (int o = 1; o < 64; o <<= 1) v += __shfl_xor(v, o);
    return v;
}
DI u32x4 pack8(const f32x4& a, const f32x4& b) { u32x4 w; w.x = pk2(a[0], a[1]); w.y = pk2(a[2], a[3]); w.z = pk2(b[0], b[1]); w.w = pk2(b[2], b[3]); return w; }
DI void unpack8(const u32x4& w, float (&f)[8]) { f[0] = bflo(w.x); f[1] = bfhi(w.x); f[2] = bflo(w.y); f[3] = bfhi(w.y); f[4] = bflo(w.z); f[5] = bfhi(w.z); f[6] = bflo(w.w); f[7] = bfhi(w.w); }

namespace pg8 {
constexpr int BM = 256, BK = 64, HALF = 128, HTB = HALF * BK * 2, STAGE_BYTES = 8 * HTB, NXCD = 8, WGM = 8;
DI int lds_byte(int r, int c) { const int st = (r >> 4) * 2 + (c >> 5), rr = r & 15, cc = c & 31, ob = rr * 64 + cc * 2; return st * 1024 + (ob ^ (((ob >> 9) & 1) << 5)); }
DI void stage_rc(int b, int& R, int& C) { const int st = b / 1024, sb = b % 1024, swz = sb ^ (((sb >> 9) & 1) << 5); R = (st >> 1) * 16 + swz / 64; C = (st & 1) * 32 + (swz % 64) / 2; }
DI int perm32(int rho) { const int n = rho >> 4, i = rho & 15; return 8 * (i >> 2) + 4 * n + (i & 3); }

struct Unit { int pm, pn, part; };
struct Order {
    int nM, nN, nwg, G, c, parts, K;
    const bf16_t *A0, *A1, *B0, *B1;
    DI void init(int nM_, int nN_, int G_, int c_, int K_, const bf16_t* a0, const bf16_t* b0, int parts_ = 1, const bf16_t* a1 = nullptr, const bf16_t* b1 = nullptr) {
        nM = nM_; nN = nN_; nwg = nM * nN; G = G_; c = c_; K = K_; parts = parts_; A0 = a0; B0 = b0; A1 = a1; B1 = b1; }
    DI bool next(int i, Unit& u) const {
        const int ti = (parts == 2) ? (i >> 1) : i; u.part = (parts == 2) ? (i & 1) : 0;
        const long L = (long)ti * G + c; if (L >= nwg) return false;
        int wgid = (int)L; { const int q = nwg / NXCD, r = nwg % NXCD, xcd = wgid % NXCD, off = wgid / NXCD; wgid = (xcd < r ? xcd * (q + 1) : r * (q + 1) + (xcd - r) * q) + off; }
        const int nig = WGM * nN, gid = wgid / nig, fm = gid * WGM, gsz = (nM - fm) < WGM ? (nM - fm) : WGM;
        u.pm = fm + ((wgid % nig) % gsz); u.pn = (wgid % nig) / gsz; return true;
    }
    DI const char* pa(const Unit& u) const { return (const char*)(u.part ? A1 : A0) + (size_t)u.pm * BM * K * 2; }
    DI const char* pb(const Unit& u) const { return (const char*)(u.part ? B1 : B0) + (size_t)u.pn * BM * K * 2; }
};

template <class Epi>
__device__ __forceinline__ void gemm_phase(LAS unsigned char* lds, const Order& S, const Epi& E) {
    const int tid = threadIdx.x, wid = __builtin_amdgcn_readfirstlane(tid >> 6), lane = tid & 63, wr = wid >> 2, wc = wid & 3, fr = lane & 15, fq = lane >> 4;
    const int K = S.K, nt = K / BK;
    unsigned voffA[2], voffB[2];
#pragma unroll
    for (int i = 0; i < 2; ++i) { int R, C; stage_rc(tid * 16 + i * 8192, R, C); const int Rb = (R & ~31) + perm32(R & 31);
        voffA[i] = (unsigned)(R * K + C) * 2u; voffB[i] = (unsigned)(Rb * K + C) * 2u; }
    const size_t kstep = (size_t)(BK * 2);
    const size_t hstep = (size_t)HALF * K * 2;
    const unsigned ldsw = (unsigned)wid * 1024u;
    const int aoff = lds_byte(wr * 64 + fr, fq * 8), boff = lds_byte(wc * 32 + fr, fq * 8);
#define PG8_SA(b, h) (((b) * 2 + (h)) * HTB)
#define PG8_SB(b, h) ((4 + (b) * 2 + (h)) * HTB)
#define PG8_STAGE(bufoff, gbase, voff) do { _Pragma("unroll") for (int _i = 0; _i < 2; ++_i) \
        __builtin_amdgcn_global_load_lds((const unsigned*)((const char*)(gbase) + (voff)[_i]), (LAS unsigned*)(lds + (bufoff) + ldsw + _i * 8192), 16, 0, 0); } while (0)
#define PG8_LDA(dst, b, h) do { _Pragma("unroll") for (int m = 0; m < 4; ++m) _Pragma("unroll") for (int k = 0; k < 2; ++k) dst[m][k] = *(const LAS bf16x8*)(lds + PG8_SA(b, h) + aoff + m * 2048 + k * 1024); } while (0)
#define PG8_LDB(dst, b, h) do { _Pragma("unroll") for (int n = 0; n < 2; ++n) _Pragma("unroll") for (int k = 0; k < 2; ++k) dst[n][k] = *(const LAS bf16x8*)(lds + PG8_SB(b, h) + boff + n * 2048 + k * 1024); } while (0)
#define PG8_MMA(ai, bj, At, Bt) do { __builtin_amdgcn_s_setprio(1); _Pragma("unroll") for (int m = 0; m < 4; ++m) _Pragma("unroll") for (int n = 0; n < 2; ++n) _Pragma("unroll") for (int k = 0; k < 2; ++k) \
        acc[ai][bj][m][n] = __builtin_amdgcn_mfma_f32_16x16x32_bf16(Bt[n][k], At[m][k], acc[ai][bj][m][n], 0, 0, 0); __builtin_amdgcn_s_setprio(0); } while (0)
#define PG8_WAIT_V(n) asm volatile("s_waitcnt vmcnt(" #n ")" ::: "memory")
#define PG8_WAIT_L(n) asm volatile("s_waitcnt lgkmcnt(" #n ")" ::: "memory")
#define PG8_BAR __builtin_amdgcn_s_barrier()
#define PG8_SCHED __builtin_amdgcn_sched_barrier(0)
    Unit cur, nxt; int ui = 0;
    if (!S.next(0, cur)) return;
    f32x4 acc[2][2][4][2];
#pragma unroll
    for (int a = 0; a < 2; ++a)
#pragma unroll
        for (int b = 0; b < 2; ++b)
#pragma unroll
            for (int m = 0; m < 4; ++m)
#pragma unroll
                for (int n = 0; n < 2; ++n) acc[a][b][m][n] = (f32x4){0.f, 0.f, 0.f, 0.f};
    bf16x8 At[4][2], B0[2][2], B1[2][2];
    const char* cA = S.pa(cur); const char* cB = S.pb(cur);
    PG8_STAGE(PG8_SB(0, 0), cB, voffB); PG8_STAGE(PG8_SA(0, 0), cA, voffA); PG8_STAGE(PG8_SB(0, 1), cB + hstep, voffB); PG8_STAGE(PG8_SA(0, 1), cA + hstep, voffA);
    if (wr == 1) PG8_BAR;
    PG8_WAIT_V(4); PG8_BAR;
    PG8_STAGE(PG8_SB(1, 0), cB + kstep, voffB); PG8_STAGE(PG8_SA(1, 0), cA + kstep, voffA); PG8_STAGE(PG8_SB(1, 1), cB + hstep + kstep, voffB);
    PG8_WAIT_V(6); PG8_BAR;
    for (;;) {
        const bool has_next = S.next(ui + 1, nxt);
        const char* nA = has_next ? S.pa(nxt) : cA; const char* nB = has_next ? S.pb(nxt) : cB;
        for (int t = 0; t < nt; t += 2) {
            const bool last = (t == nt - 2);
            const char* a1 = cA + (size_t)(t + 1) * kstep;
            const char* a2 = last ? nA : cA + (size_t)(t + 2) * kstep; const char* b2 = last ? nB : cB + (size_t)(t + 2) * kstep;
            const char* a3 = a2 + kstep; const char* b3 = b2 + kstep;
            PG8_LDB(B0, 0, 0); PG8_SCHED; PG8_LDA(At, 0, 0); PG8_STAGE(PG8_SA(1, 1), a1 + hstep, voffA);
            PG8_WAIT_L(8); PG8_BAR; PG8_WAIT_L(0); PG8_MMA(0, 0, At, B0); PG8_BAR; PG8_SCHED;
            PG8_LDB(B1, 0, 1); PG8_STAGE(PG8_SB(0, 0), b2, voffB);
            PG8_BAR; PG8_WAIT_L(0); PG8_MMA(0, 1, At, B1); PG8_BAR;
            PG8_LDA(At, 0, 1); PG8_STAGE(PG8_SA(0, 0), a2, voffA);
            PG8_BAR; PG8_WAIT_L(0); PG8_MMA(1, 0, At, B0); PG8_BAR; PG8_SCHED;
            PG8_STAGE(PG8_SB(0, 1), b2 + hstep, voffB);
            PG8_WAIT_V(6); PG8_BAR; PG8_MMA(1, 1, At, B1); PG8_BAR;
            PG8_LDB(B0, 1, 0); PG8_SCHED; PG8_LDA(At, 1, 0); PG8_STAGE(PG8_SA(0, 1), a2 + hstep, voffA);
            PG8_WAIT_L(8); PG8_BAR; PG8_WAIT_L(0); PG8_MMA(0, 0, At, B0); PG8_BAR; PG8_SCHED;
            PG8_LDB(B1, 1, 1); PG8_STAGE(PG8_SB(1, 0), b3, voffB);
            PG8_BAR; PG8_WAIT_L(0); PG8_MMA(0, 1, At, B1); PG8_BAR;
            PG8_LDA(At, 1, 1); PG8_STAGE(PG8_SA(1, 0), a3, voffA);
            PG8_BAR; PG8_WAIT_L(0); PG8_MMA(1, 0, At, B0); PG8_BAR; PG8_SCHED;
            PG8_STAGE(PG8_SB(1, 1), b3 + hstep, voffB);
            PG8_WAIT_V(6); PG8_BAR; PG8_MMA(1, 1, At, B1); PG8_BAR;
        }
        E(acc, cur, wr, wc, fr, fq);
        if (!has_next) break;
        if (!E.keep(cur)) {
#pragma unroll
            for (int a = 0; a < 2; ++a)
#pragma unroll
                for (int b = 0; b < 2; ++b)
#pragma unroll
                    for (int m = 0; m < 4; ++m)
#pragma unroll
                        for (int n = 0; n < 2; ++n) acc[a][b][m][n] = (f32x4){0.f, 0.f, 0.f, 0.f};
        }
        cur = nxt; cA = nA; cB = nB; ++ui;
    }
    PG8_WAIT_V(0);
    if (wr == 0) PG8_BAR;
    PG8_BAR;
#undef PG8_SA
#undef PG8_SB
#undef PG8_STAGE
#undef PG8_LDA
#undef PG8_LDB
#undef PG8_MMA
#undef PG8_WAIT_V
#undef PG8_WAIT_L
#undef PG8_BAR
#undef PG8_SCHED
}

typedef f32x4 Acc[2][2][4][2];
struct EpiProjH {
    bf16_t* seg; const float* lbl;
    DI bool keep(const Unit&) const { return false; }
    DI void operator()(Acc& acc, const Unit& u, int wr, int wc, int fr, int fq) const {
        const int colt = u.pn * BM, sg = colt >> 10, cb = (colt & 1023) + wc * 32 + 8 * fq;
        bf16_t* base = seg + (size_t)sg * MT * 1024;
#pragma unroll
        for (int bj = 0; bj < 2; ++bj) {
            const int c0 = cb + bj * HALF;
            float lb[8];
            if (sg == 1) {
#pragma unroll
                for (int j = 0; j < 8; ++j) lb[j] = sigm(lbl[c0 + j] - lbl[1024 + c0 + j]);
            }
#pragma unroll
            for (int ai = 0; ai < 2; ++ai)
#pragma unroll
                for (int m = 0; m < 4; ++m) {
                    const int row = u.pm * BM + wr * 64 + fr + ai * HALF + m * 16;
                    float v[8];
#pragma unroll
                    for (int j = 0; j < 4; ++j) { v[j] = acc[ai][bj][m][0][j]; v[4 + j] = acc[ai][bj][m][1][j]; }
                    if (sg == 0 || sg == 3) {
#pragma unroll
                        for (int j = 0; j < 8; ++j) v[j] = silu(v[j]);
                    } else if (sg == 1) {
#pragma unroll
                        for (int j = 0; j < 8; ++j) v[j] = __logf(lb[j] + (1.0f - lb[j]) * sigm(v[j]));
                    }
                    u32x4 w; w.x = pk2(v[0], v[1]); w.y = pk2(v[2], v[3]); w.z = pk2(v[4], v[5]); w.w = pk2(v[6], v[7]);
                    *(u32x4*)(base + (size_t)row * 1024 + c0) = w;
                }
        }
    }
};
struct EpiProjL {
    bf16_t* seg; float* out;
    DI bool keep(const Unit&) const { return false; }
    DI void operator()(Acc& acc, const Unit& u, int wr, int wc, int fr, int fq) const {
        const int colt = u.pn * BM, sg = colt >> 10, cb = (colt & 1023) + wc * 32 + 8 * fq;
        bf16_t* base = seg + (size_t)sg * MT * 1024;
#pragma unroll
        for (int bj = 0; bj < 2; ++bj) {
            const int c0 = cb + bj * HALF;
#pragma unroll
            for (int ai = 0; ai < 2; ++ai)
#pragma unroll
                for (int m = 0; m < 4; ++m) {
                    const int row = u.pm * BM + wr * 64 + fr + ai * HALF + m * 16;
                    float v[8];
#pragma unroll
                    for (int j = 0; j < 4; ++j) { v[j] = acc[ai][bj][m][0][j]; v[4 + j] = acc[ai][bj][m][1][j]; }
                    if (sg == 0) {
                        float* dst = nullptr;
                        if (row < MP) { const int t = row & (TSEQ - 1); if (t >= TSEQ - 3) dst = out + O_CVP + ((size_t)(row >> 11) * 3 + (t - (TSEQ - 3))) * 1024 + c0; }
                        else if (row < MR) dst = out + O_CVS + ((size_t)(row - MP) * 3 + 2) * 1024 + c0;
                        if (dst) { *(f32x4*)dst = acc[ai][bj][m][0]; *(f32x4*)(dst + 4) = acc[ai][bj][m][1]; }
                    } else if (sg == 1) {
#pragma unroll
                        for (int j = 0; j < 8; ++j) v[j] = gelu_tanh(v[j]);
                    } else {
#pragma unroll
                        for (int j = 0; j < 8; ++j) v[j] = sigm(v[j]);
                    }
                    u32x4 w; w.x = pk2(v[0], v[1]); w.y = pk2(v[2], v[3]); w.z = pk2(v[4], v[5]); w.w = pk2(v[6], v[7]);
                    *(u32x4*)(base + (size_t)row * 1024 + c0) = w;
                }
        }
    }
};
struct EpiMerge {
    const bf16_t *sga, *sgb; bf16_t* dst;
    DI bool keep(const Unit& u) const { return u.part == 0; }
    DI void operator()(Acc& acc, const Unit& u, int wr, int wc, int fr, int fq) const {
#pragma unroll
        for (int bj = 0; bj < 2; ++bj) {
            const int c0 = u.pn * BM + wc * 32 + 8 * fq + bj * HALF;
#pragma unroll
            for (int ai = 0; ai < 2; ++ai)
#pragma unroll
                for (int m = 0; m < 4; ++m) {
                    const int row = u.pm * BM + wr * 64 + fr + ai * HALF + m * 16;
                    const size_t off = (size_t)row * 1024 + c0;
                    float gb[8]; unpack8(*(const u32x4*)(sgb + off), gb);
                    if (u.part == 0) {
                        float ga[8]; unpack8(*(const u32x4*)(sga + off), ga);
#pragma unroll
                        for (int j = 0; j < 4; ++j) { acc[ai][bj][m][0][j] *= ga[j] * frcp(gb[j]); acc[ai][bj][m][1][j] *= ga[4 + j] * frcp(gb[4 + j]); }
                    } else {
                        float v[8];
#pragma unroll
                        for (int j = 0; j < 4; ++j) { v[j] = acc[ai][bj][m][0][j] * gb[j]; v[4 + j] = acc[ai][bj][m][1][j] * gb[4 + j]; }
                        u32x4 w; w.x = pk2(v[0], v[1]); w.y = pk2(v[2], v[3]); w.z = pk2(v[4], v[5]); w.w = pk2(v[6], v[7]);
                        *(u32x4*)(dst + off) = w;
                    }
                }
        }
    }
};
struct EpiF32 {
    float* C;
    DI bool keep(const Unit&) const { return false; }
    DI void operator()(Acc& acc, const Unit& u, int wr, int wc, int fr, int fq) const {
#pragma unroll
        for (int bj = 0; bj < 2; ++bj) {
            const int c0 = u.pn * BM + wc * 32 + 8 * fq + bj * HALF;
#pragma unroll
            for (int ai = 0; ai < 2; ++ai)
#pragma unroll
                for (int m = 0; m < 4; ++m) {
                    const int row = u.pm * BM + wr * 64 + fr + ai * HALF + m * 16;
                    float* p = C + (size_t)row * 1024 + c0;
                    *(f32x4*)p = acc[ai][bj][m][0]; *(f32x4*)(p + 4) = acc[ai][bj][m][1];
                }
        }
    }
};
struct EpiSwiGLU {
    bf16_t* act;
    DI bool keep(const Unit&) const { return false; }
    DI void operator()(Acc& acc, const Unit& u, int wr, int wc, int fr, int fq) const {
        const int c0 = u.pn * HALF + wc * 32 + 8 * fq;
#pragma unroll
        for (int ai = 0; ai < 2; ++ai)
#pragma unroll
            for (int m = 0; m < 4; ++m) {
                const int row = u.pm * BM + wr * 64 + fr + ai * HALF + m * 16;
                float v[8];
#pragma unroll
                for (int j = 0; j < 4; ++j) { v[j] = silu(acc[ai][0][m][0][j]) * acc[ai][1][m][0][j]; v[4 + j] = silu(acc[ai][0][m][1][j]) * acc[ai][1][m][1][j]; }
                u32x4 w; w.x = pk2(v[0], v[1]); w.y = pk2(v[2], v[3]); w.z = pk2(v[4], v[5]); w.w = pk2(v[6], v[7]);
                *(u32x4*)(act + (size_t)row * DFF + c0) = w;
            }
    }
};
}

DI void p0_transpose_item(const float* W, int N, int k0, int src_n0, bf16_t* WT, int Kdst, int dst_r0, LAS float* scr, int lane) {
#pragma unroll 8
    for (int i = 0; i < 32; ++i) { const int kk = 2 * i + (lane >> 5); scr[kk * 33 + (lane & 31)] = W[(size_t)(k0 + kk) * N + src_n0 + (lane & 31)]; }
    asm volatile("s_waitcnt lgkmcnt(0)" ::: "memory");
    const int c = lane & 7;
#pragma unroll
    for (int j = 0; j < 4; ++j) { const int n = (lane >> 3) + 8 * j; const LAS float* s = scr + (8 * c) * 33 + n;
        u32x4 o; o.x = pk2(s[0 * 33], s[1 * 33]); o.y = pk2(s[2 * 33], s[3 * 33]); o.z = pk2(s[4 * 33], s[5 * 33]); o.w = pk2(s[6 * 33], s[7 * 33]);
        *(u32x4*)(WT + (size_t)(dst_r0 + n) * Kdst + k0 + 8 * c) = o; }
    asm volatile("s_waitcnt lgkmcnt(0)" ::: "memory");
}
DI const float* xrow_ptr(const Params& p, int row) { return row < MP ? p.in[0] + (size_t)row * DM : p.in[1] + (size_t)(row - MP) * DM; }

DI void phase_prep(const Params& p, LAS unsigned char* lds) {
    const int tid = threadIdx.x, lane = tid & 63, wave = tid >> 6;
    const int gw = blockIdx.x * 8 + wave, NGW = gridDim.x * 8;
    LAS float* scr = (LAS float*)(lds + wave * 16384);
    unsigned char* ws = p.ws;
    constexpr int I_IN = 16 * 256, I_SQ = 16 * 32, I_FI = 16 * 176, I_FO = 44 * 32, I_L = 8 * 8;
    constexpr int NITEMS = I_IN + 3 * I_SQ + I_FI + I_FO + 2 * I_L;
    for (int it = gw; it < NITEMS; it += NGW) {
        int r = it;
        if (r < I_IN) { const int kb = r / 256, nb = r % 256; p0_transpose_item(p.in[9], 8192, 64 * kb, 32 * nb, (bf16_t*)(ws + WS_WIN), 1024, 32 * nb, scr, lane); continue; } r -= I_IN;
        if (r < 3 * I_SQ) { const int w = r / I_SQ, q = r % I_SQ, kb = q / 32, nb = q % 32;
            p0_transpose_item(p.in[w == 0 ? 19 : (w == 1 ? 20 : 21)], 1024, 64 * kb, 32 * nb, (bf16_t*)(ws + (w == 0 ? WS_WPA : (w == 1 ? WS_WPB : WS_WO))), 1024, 32 * nb, scr, lane); continue; } r -= 3 * I_SQ;
        if (r < I_FI) { const int kb = r / 176, nb = r % 176, d0 = 32 * nb, pn = d0 >> 8, h = (d0 >> 7) & 1, j = d0 & 127;
            p0_transpose_item(p.in[22], NFI, 64 * kb, h * DFF + pn * 128 + j, (bf16_t*)(ws + WS_WFI), 1024, d0, scr, lane); continue; } r -= I_FI;
        if (r < I_FO) { const int kb = r / 32, nb = r % 32; p0_transpose_item(p.in[23], 1024, 64 * kb, 32 * nb, (bf16_t*)(ws + WS_WFO), DFF, 32 * nb, scr, lane); continue; } r -= I_FO;
        { const int w = r / I_L, q = r % I_L, blk = q / 8, kb = (q % 8) / 4, nb = q % 4;
          p0_transpose_item(p.in[w == 0 ? 14 : 16] + (size_t)blk * 16384, 128, 64 * kb, 32 * nb, (bf16_t*)(ws + (w == 0 ? WS_WLA : WS_WLX)) + (size_t)blk * 16384, 128, 32 * nb, scr, lane); }
    }
    bf16_t* XN = (bf16_t*)p.out;
    const float* g = p.in[5];
    for (int m = gw; m < MT; m += NGW) {
        u32x2* o = (u32x2*)(XN + (size_t)m * DM) + lane;
        if (m >= MR) {
#pragma unroll
            for (int j = 0; j < 4; ++j) o[64 * j] = (u32x2){0u, 0u};
            continue; }
        const f32x4* xr = (const f32x4*)xrow_ptr(p, m) + lane;
        f32x4 v[4]; float s = 0.f;
#pragma unroll
        for (int j = 0; j < 4; ++j) { v[j] = xr[64 * j]; s += (v[j].x * v[j].x + v[j].y * v[j].y) + (v[j].z * v[j].z + v[j].w * v[j].w); }
        const float rstd = rsqrtf(wave_sum(s) * (1.f / DM) + EPS);
#pragma unroll
        for (int j = 0; j < 4; ++j) { const f32x4 gg = ((const f32x4*)g)[lane + 64 * j];
            o[64 * j] = (u32x2){pk2(v[j].x * rstd * gg.x, v[j].y * rstd * gg.y), pk2(v[j].z * rstd * gg.z, v[j].w * rstd * gg.w)}; }
    }
    for (int i = blockIdx.x * NTHREADS + tid; i < MS * 2 * 1024; i += gridDim.x * NTHREADS) {
        const int b = i / 2048, r = (i / 1024) & 1, c = i & 1023;
        p.out[O_CVS + ((size_t)b * 3 + r) * 1024 + c] = p.in[4][((size_t)b * 3 + r + 1) * 1024 + c];
    }
}

DI void phase_r1(const Params& p, const float* MO, bf16_t* HN) {
    const int tid = threadIdx.x, lane = tid & 63, wave = tid >> 6;
    const int gw = blockIdx.x * 8 + wave, NGW = gridDim.x * 8;
    const float* g1 = p.in[6]; const float* g2 = p.in[7];
    for (int m = gw; m < MR; m += NGW) {
        const f32x4* xr = (const f32x4*)xrow_ptr(p, m) + lane;
        const f32x4* mr = (const f32x4*)(MO + (size_t)m * DM) + lane;
        f32x4 x[4], o[4]; float s = 0.f;
#pragma unroll
        for (int j = 0; j < 4; ++j) { x[j] = xr[64 * j]; o[j] = mr[64 * j]; s += (o[j].x * o[j].x + o[j].y * o[j].y) + (o[j].z * o[j].z + o[j].w * o[j].w); }
        const float r1 = rsqrtf(wave_sum(s) * (1.f / DM) + EPS);
        float s2 = 0.f;
#pragma unroll
        for (int j = 0; j < 4; ++j) { const f32x4 gg = ((const f32x4*)g1)[lane + 64 * j]; x[j] = x[j] + o[j] * r1 * gg; s2 += (x[j].x * x[j].x + x[j].y * x[j].y) + (x[j].z * x[j].z + x[j].w * x[j].w); }
        const float r2 = rsqrtf(wave_sum(s2) * (1.f / DM) + EPS);
        f32x4* yo = (f32x4*)(p.out + O_Y + (size_t)m * DM) + lane;
        u32x2* ho = (u32x2*)(HN + (size_t)m * DM) + lane;
#pragma unroll
        for (int j = 0; j < 4; ++j) { yo[64 * j] = x[j]; const f32x4 gg = ((const f32x4*)g2)[lane + 64 * j];
            ho[64 * j] = (u32x2){pk2(x[j].x * r2 * gg.x, x[j].y * r2 * gg.y), pk2(x[j].z * r2 * gg.z, x[j].w * r2 * gg.w)}; }
    }
}
DI void phase_r2(const Params& p, const float* FO) {
    const int tid = threadIdx.x, lane = tid & 63, wave = tid >> 6;
    const int gw = blockIdx.x * 8 + wave, NGW = gridDim.x * 8;
    const float* g = p.in[8];
    for (int m = gw; m < MR; m += NGW) {
        f32x4* yr = (f32x4*)(p.out + O_Y + (size_t)m * DM) + lane;
        const f32x4* fr = (const f32x4*)(FO + (size_t)m * DM) + lane;
        f32x4 x[4], o[4]; float s = 0.f;
#pragma unroll
        for (int j = 0; j < 4; ++j) { x[j] = yr[64 * j]; o[j] = fr[64 * j]; s += (o[j].x * o[j].x + o[j].y * o[j].y) + (o[j].z * o[j].z + o[j].w * o[j].w); }
        const float r1 = rsqrtf(wave_sum(s) * (1.f / DM) + EPS);
#pragma unroll
        for (int j = 0; j < 4; ++j) { const f32x4 gg = ((const f32x4*)g)[lane + 64 * j]; yr[64 * j] = x[j] + o[j] * r1 * gg; }
    }
}

constexpr int HG_GRAW = 0, HG_BC = 16384, HG_TOT = 49152, HG_QT = 51200, HG_KT = 68608, HG_KTT = 86016, HG_VT = 104448, HG_PB = 122880, HG_OB = 0, HG_END = 132096;
constexpr int QS = 136, TS = 72, OS = 132;

DI void hgrn_prompt_item(const Params& p, LAS unsigned char* lds, int b, int h) {
    const int tid = threadIdx.x, lane = tid & 63, w = tid >> 6, fr = lane & 15, fg = lane >> 4;
    const bf16_t* SQ = (const bf16_t*)(p.ws + WS_SEG);
    const bf16_t* SG = SQ + (size_t)MT * 1024; const bf16_t* SV = SG + (size_t)MT * 1024; const bf16_t* SO = SV + (size_t)MT * 1024;
    bf16_t* AIN = (bf16_t*)(p.ws + WS_AIN);
    LAS bf16_t* Graw = (LAS bf16_t*)(lds + HG_GRAW); LAS float* BC = (LAS float*)(lds + HG_BC); LAS float* TOT = (LAS float*)(lds + HG_TOT);
    LAS bf16_t* QT = (LAS bf16_t*)(lds + HG_QT); LAS bf16_t* KT = (LAS bf16_t*)(lds + HG_KT); LAS bf16_t* KTT = (LAS bf16_t*)(lds + HG_KTT);
    LAS bf16_t* VT = (LAS bf16_t*)(lds + HG_VT); LAS bf16_t* PB = (LAS bf16_t*)(lds + HG_PB); LAS float* OB = (LAS float*)(lds + HG_OB);
    const int as = tid >> 3, akg = tid & 7;
    const int bk = tid & 127, bj = tid >> 7;
    f32x4 Sacc[8];
#pragma unroll
    for (int i = 0; i < 8; ++i) Sacc[i] = (f32x4){0.f, 0.f, 0.f, 0.f};
    const size_t rowbase = (size_t)b * TSEQ;
    const int colh = h * 128;
    u32x4 rq[2], rg[2], rv[2];
    { const size_t off = (rowbase + as) * 1024 + colh + 16 * akg;
      rq[0] = *(const u32x4*)(SQ + off); rq[1] = *(const u32x4*)(SQ + off + 8); rg[0] = *(const u32x4*)(SG + off); rg[1] = *(const u32x4*)(SG + off + 8);
      rv[0] = *(const u32x4*)(SV + off); rv[1] = *(const u32x4*)(SV + off + 8); }
    const float on_lo = 0.f; (void)on_lo;
    for (int c = 0; c < TSEQ / 64; ++c) {
        *(LAS u32x4*)(Graw + as * 128 + 16 * akg) = rg[0]; *(LAS u32x4*)(Graw + as * 128 + 16 * akg + 8) = rg[1];
        { const unsigned vw[8] = {rv[0].x, rv[0].y, rv[0].z, rv[0].w, rv[1].x, rv[1].y, rv[1].z, rv[1].w};
#pragma unroll
          for (int i = 0; i < 8; ++i) { VT[(16 * akg + 2 * i) * TS + as] = (bf16_t)(vw[i] & 0xffffu); VT[(16 * akg + 2 * i + 1) * TS + as] = (bf16_t)(vw[i] >> 16); } }
        float qf[16], gf[16];
        unpack8(rq[0], *(float(*)[8])&qf[0]); unpack8(rq[1], *(float(*)[8])&qf[8]);
        unpack8(rg[0], *(float(*)[8])&gf[0]); unpack8(rg[1], *(float(*)[8])&gf[8]);
        if (c + 1 < TSEQ / 64) { const size_t off = (rowbase + (size_t)(c + 1) * 64 + as) * 1024 + colh + 16 * akg;
            rq[0] = *(const u32x4*)(SQ + off); rq[1] = *(const u32x4*)(SQ + off + 8); rg[0] = *(const u32x4*)(SG + off); rg[1] = *(const u32x4*)(SG + off + 8);
            rv[0] = *(const u32x4*)(SV + off); rv[1] = *(const u32x4*)(SV + off + 8); }
        __syncthreads();
        float gl[16], lc[16];
        { float run = 0.f;
#pragma unroll
          for (int i = 0; i < 16; ++i) { gl[i] = bf2f(Graw[(16 * bj + i) * 128 + bk]); run += gl[i]; lc[i] = run; }
          TOT[bj * 128 + bk] = run; }
        __syncthreads();
        float base = 0.f, total = 0.f;
#pragma unroll
        for (int j = 0; j < 4; ++j) { const float t = TOT[j * 128 + bk]; base += (j < bj) ? t : 0.f; total += t; }
        {
            unsigned kw[8];
#pragma unroll
            for (int i = 0; i < 16; i += 2) {
                const float b0 = base + lc[i], b1 = base + lc[i + 1];
                BC[(16 * bj + i) * 128 + bk] = b0; BC[(16 * bj + i + 1) * 128 + bk] = b1;
                const float k0 = (1.0f - fexp(gl[i])) * fexp(total - b0), k1 = (1.0f - fexp(gl[i + 1])) * fexp(total - b1);
                kw[i >> 1] = pk2(k0, k1);
            }
            *(LAS u32x4*)(KTT + bk * TS + 16 * bj) = (u32x4){kw[0], kw[1], kw[2], kw[3]};
            *(LAS u32x4*)(KTT + bk * TS + 16 * bj + 8) = (u32x4){kw[4], kw[5], kw[6], kw[7]};
        }
        __syncthreads();
        {
            float bc[16];
#pragma unroll
            for (int i = 0; i < 4; ++i) { const f32x4 t = *(const LAS f32x4*)(BC + as * 128 + 16 * akg + 4 * i); bc[4 * i] = t.x; bc[4 * i + 1] = t.y; bc[4 * i + 2] = t.z; bc[4 * i + 3] = t.w; }
            unsigned qw[8], kw[8];
#pragma unroll
            for (int i = 0; i < 16; i += 2) {
                const float e0 = fexp(bc[i]), e1 = fexp(bc[i + 1]);
                const float n0 = fexp(fminf(-bc[i], 80.f)), n1 = fexp(fminf(-bc[i + 1], 80.f));
                qw[i >> 1] = pk2(qf[i] * e0, qf[i + 1] * e1);
                kw[i >> 1] = pk2((1.0f - fexp(gf[i])) * n0, (1.0f - fexp(gf[i + 1])) * n1);
            }
            *(LAS u32x4*)(QT + as * QS + 16 * akg) = (u32x4){qw[0], qw[1], qw[2], qw[3]}; *(LAS u32x4*)(QT + as * QS + 16 * akg + 8) = (u32x4){qw[4], qw[5], qw[6], qw[7]};
            *(LAS u32x4*)(KT + as * QS + 16 * akg) = (u32x4){kw[0], kw[1], kw[2], kw[3]}; *(LAS u32x4*)(KT + as * QS + 16 * akg + 8) = (u32x4){kw[4], kw[5], kw[6], kw[7]};
        }
        __syncthreads();
#pragma unroll
        for (int q2 = 0; q2 < 2; ++q2) {
            const int id = 2 * w + q2, ti = id >> 2, si = id & 3;
            f32x4 pacc = (f32x4){0.f, 0.f, 0.f, 0.f};
            if (si <= ti) {
#pragma unroll
                for (int ks = 0; ks < 4; ++ks) {
                    const bf16x8 a = *(const LAS bf16x8*)(KT + (16 * si + fr) * QS + 32 * ks + 8 * fg);
                    const bf16x8 bq = *(const LAS bf16x8*)(QT + (16 * ti + fr) * QS + 32 * ks + 8 * fg);
                    pacc = __builtin_amdgcn_mfma_f32_16x16x32_bf16(a, bq, pacc, 0, 0, 0);
                }
            }
            const int t = 16 * ti + fr, s0 = 16 * si + 4 * fg;
            float pv[4];
#pragma unroll
            for (int j = 0; j < 4; ++j) pv[j] = (s0 + j <= t) ? pacc[j] : 0.f;
            *(LAS u32x2*)(PB + t * TS + s0) = (u32x2){pk2(pv[0], pv[1]), pk2(pv[2], pv[3])};
        }
        f32x4 oacc[4];
#pragma unroll
        for (int ti = 0; ti < 4; ++ti) oacc[ti] = (f32x4){0.f, 0.f, 0.f, 0.f};
#pragma unroll
        for (int pp = 0; pp < 4; ++pp) {
            const u32x4 sb = pack8(Sacc[2 * pp], Sacc[2 * pp + 1]);
            const bf16x8 bfrag = __builtin_bit_cast(bf16x8, sb);
#pragma unroll
            for (int ti = 0; ti < 4; ++ti) {
                const u32x2 lo = *(const LAS u32x2*)(QT + (16 * ti + fr) * QS + 32 * pp + 4 * fg);
                const u32x2 hi = *(const LAS u32x2*)(QT + (16 * ti + fr) * QS + 32 * pp + 16 + 4 * fg);
                const bf16x8 a = __builtin_bit_cast(bf16x8, (u32x4){lo.x, lo.y, hi.x, hi.y});
                oacc[ti] = __builtin_amdgcn_mfma_f32_16x16x32_bf16(a, bfrag, oacc[ti], 0, 0, 0);
            }
        }
        {
            const float dk = 0.f; (void)dk;
            bf16x8 vb[2];
#pragma unroll
            for (int ks = 0; ks < 2; ++ks) vb[ks] = *(const LAS bf16x8*)(VT + (16 * w + fr) * TS + 32 * ks + 8 * fg);
#pragma unroll
            for (int kt = 0; kt < 8; ++kt) {
                float dsc[4];
#pragma unroll
                for (int j = 0; j < 4; ++j) { const int k = 16 * kt + 4 * fg + j; dsc[j] = fexp(TOT[k] + TOT[128 + k] + TOT[256 + k] + TOT[384 + k]); }
                f32x4 sa = Sacc[kt];
#pragma unroll
                for (int j = 0; j < 4; ++j) sa[j] *= dsc[j];
#pragma unroll
                for (int ks = 0; ks < 2; ++ks) {
                    const bf16x8 a = *(const LAS bf16x8*)(KTT + (16 * kt + fr) * TS + 32 * ks + 8 * fg);
                    sa = __builtin_amdgcn_mfma_f32_16x16x32_bf16(a, vb[ks], sa, 0, 0, 0);
                }
                Sacc[kt] = sa;
            }
            __syncthreads();
#pragma unroll
            for (int ti = 0; ti < 4; ++ti) {
#pragma unroll
                for (int ks = 0; ks < 2; ++ks) {
                    if (ks * 32 <= ti * 16 + 15) {
                        const bf16x8 a = *(const LAS bf16x8*)(PB + (16 * ti + fr) * TS + 32 * ks + 8 * fg);
                        oacc[ti] = __builtin_amdgcn_mfma_f32_16x16x32_bf16(a, vb[ks], oacc[ti], 0, 0, 0);
                    }
                }
            }
        }
#pragma unroll
        for (int ti = 0; ti < 4; ++ti)
#pragma unroll
            for (int j = 0; j < 4; ++j) OB[(16 * ti + 4 * fg + j) * OS + 16 * w + fr] = oacc[ti][j];
        __syncthreads();
        {
            float o[16]; float ss = 0.f;
#pragma unroll
            for (int i = 0; i < 4; ++i) { const f32x4 t = *(const LAS f32x4*)(OB + as * OS + 16 * akg + 4 * i); o[4 * i] = t.x; o[4 * i + 1] = t.y; o[4 * i + 2] = t.z; o[4 * i + 3] = t.w; ss += (t.x * t.x + t.y * t.y) + (t.z * t.z + t.w * t.w); }
            ss += __shfl_xor(ss, 1); ss += __shfl_xor(ss, 2); ss += __shfl_xor(ss, 4);
            const float rstd = rsqrtf(ss * (1.f / 128.f) + EPS);
            const size_t off = (rowbase + (size_t)c * 64 + as) * 1024 + colh + 16 * akg;
            float gt[16]; unpack8(*(const u32x4*)(SO + off), *(float(*)[8])&gt[0]); unpack8(*(const u32x4*)(SO + off + 8), *(float(*)[8])&gt[8]);
            const float* onw = p.in[11] + 16 * akg;
            unsigned ow[8];
#pragma unroll
            for (int i = 0; i < 16; i += 2) ow[i >> 1] = pk2(o[i] * rstd * onw[i] * gt[i], o[i + 1] * rstd * onw[i + 1] * gt[i + 1]);
            *(u32x4*)(AIN + off) = (u32x4){ow[0], ow[1], ow[2], ow[3]}; *(u32x4*)(AIN + off + 8) = (u32x4){ow[4], ow[5], ow[6], ow[7]};
        }
        __syncthreads();
    }
    float* so = p.out + O_HGP + ((size_t)b * 8 + h) * 16384;
#pragma unroll
    for (int kt = 0; kt < 8; ++kt)
#pragma unroll
        for (int j = 0; j < 4; ++j) so[(16 * kt + 4 * fg + j) * 128 + 16 * w + fr] = Sacc[kt][j];
}

DI void hgrn_sample_item(const Params& p, LAS unsigned char* lds, int bs, int h) {
    const int tid = threadIdx.x;
    const bf16_t* SQ = (const bf16_t*)(p.ws + WS_SEG);
    const bf16_t* SG = SQ + (size_t)MT * 1024; const bf16_t* SV = SG + (size_t)MT * 1024; const bf16_t* SO = SV + (size_t)MT * 1024;
    bf16_t* AIN = (bf16_t*)(p.ws + WS_AIN);
    LAS float* RED = (LAS float*)lds;
    LAS float* RSS = (LAS float*)(lds + 8192);
    const size_t roff = (size_t)(MP + bs) * 1024 + h * 128;
    const int v4 = (tid & 31) * 4, kq = tid >> 5;
    const float* S0 = p.in[2] + ((size_t)bs * 8 + h) * 16384;
    float* S1 = p.out + O_HGS + ((size_t)bs * 8 + h) * 16384;
    const u32x2 vw = *(const u32x2*)(SV + roff + v4);
    const f32x4 vv = (f32x4){bflo(vw.x), bfhi(vw.x), bflo(vw.y), bfhi(vw.y)};
    f32x4 op = (f32x4){0.f, 0.f, 0.f, 0.f};
#pragma unroll
    for (int i = 0; i < 8; ++i) {
        const int k = 8 * kq + i;
        const float f = fexp(bf2f(SG[roff + k])), kk = 1.0f - f, q = bf2f(SQ[roff + k]);
        const f32x4 s0 = *(const f32x4*)(S0 + (size_t)k * 128 + v4);
        const f32x4 sn = s0 * f + vv * kk;
        *(f32x4*)(S1 + (size_t)k * 128 + v4) = sn;
        op += sn * q;
    }
    *(LAS f32x4*)(RED + kq * 128 + v4) = op;
    __syncthreads();
    float o = 0.f;
    if (tid < 128) {
#pragma unroll
        for (int j = 0; j < 16; ++j) o += RED[j * 128 + tid];
        const float ss = wave_sum(o * o);
        if ((tid & 63) == 0) RSS[tid >> 6] = ss;
    }
    __syncthreads();
    if (tid < 128) {
        const float rstd = rsqrtf((RSS[0] + RSS[1]) * (1.f / 128.f) + EPS);
        const float r = o * rstd * p.in[11][tid] * bf2f(SO[roff + tid]);
        AIN[roff + tid] = (bf16_t)f2bf(r);
    }
    __syncthreads();
}

DI void phase_hgrn(const Params& p, LAS unsigned char* lds) {
    const int NI = 64 + MS * 8;
    for (int it = blockIdx.x; it < NI; it += gridDim.x) {
        if (it < 64) hgrn_prompt_item(p, lds, it >> 3, it & 7);
        else { const int r = it - 64; hgrn_sample_item(p, lds, r >> 3, r & 7); }
    }
}

constexpr int LR_XC = 0, LR_RA = 69632, LR_IX = 103424, LR_COMP = 137216, LR_END = 141312;
constexpr int XS = 136, RS = 33;
DI float neg_expm1(float x) {
    if (x > -0.1f) { return -x * (1.0f + x * (0.5f + x * (0.16666667f + x * 0.041666668f))); }
    return 1.0f - fexp(x);
}
DI void lru_item(const Params& p, LAS unsigned char* lds, bool sample, int b, int n, int dq) {
    const int tid0 = threadIdx.x, fr0 = tid0 & 15;
    const bf16_t* SLX = (const bf16_t*)(p.ws + WS_SEG); const bf16_t* SLY = SLX + (size_t)MT * 1024;
    bf16_t* BIN = (bf16_t*)(p.ws + WS_BIN);
    LAS bf16_t* XC = (LAS bf16_t*)(lds + LR_XC); LAS float* RA = (LAS float*)(lds + LR_RA); LAS float* IX = (LAS float*)(lds + LR_IX); LAS f32x2* COMP = (LAS f32x2*)(lds + LR_COMP);
    const int ch0 = n * 128;
    const float bias_a0 = p.in[15][ch0 + 32 * dq + fr0], bias_a1 = p.in[15][ch0 + 32 * dq + 16 + fr0];
    const float bias_x0 = p.in[17][ch0 + 32 * dq + fr0], bias_x1 = p.in[17][ch0 + 32 * dq + 16 + fr0];
    const float lam = p.in[18][ch0 + 32 * dq + (tid0 & 31)];
    const float sp8 = 8.0f * (lam > 15.f ? fexp(-lam) : log1pf(fexp(-lam)));
    float hcar = 0.f;
    const int ntiles = sample ? 1 : (TSEQ / 256);
    for (int tile = 0; tile < ntiles; ++tile) {
        const int t0 = tile * 256;
        int tid = threadIdx.x; asm volatile("" : "+v"(tid));
        const int lane = tid & 63, w = tid >> 6, fr = lane & 15, fg = lane >> 4;
        const int c8 = tid & 15, tr = tid >> 4;
        const int sd = tid & 31, sub = tid >> 5, sch = ch0 + 32 * dq + sd;
        {
        float cw[4][8], cbv[8];
#pragma unroll
        for (int j = 0; j < 4; ++j) { const f32x4 w0 = *(const f32x4*)(p.in[12] + j * 1024 + ch0 + 8 * c8), w1 = *(const f32x4*)(p.in[12] + j * 1024 + ch0 + 8 * c8 + 4);
            cw[j][0] = w0.x; cw[j][1] = w0.y; cw[j][2] = w0.z; cw[j][3] = w0.w; cw[j][4] = w1.x; cw[j][5] = w1.y; cw[j][6] = w1.z; cw[j][7] = w1.w; }
        { const f32x4 w0 = *(const f32x4*)(p.in[13] + ch0 + 8 * c8), w1 = *(const f32x4*)(p.in[13] + ch0 + 8 * c8 + 4);
            cbv[0] = w0.x; cbv[1] = w0.y; cbv[2] = w0.z; cbv[3] = w0.w; cbv[4] = w1.x; cbv[5] = w1.y; cbv[6] = w1.z; cbv[7] = w1.w; }
        if (!sample) {
#pragma unroll 1
            for (int hh2 = 0; hh2 < 2; ++hh2) {
                float xin[7][8];
#pragma unroll
                for (int r = 0; r < 7; ++r) {
                    const int t = t0 + 8 * tr + 4 * hh2 - 3 + r;
                    if (t >= 0) unpack8(*(const u32x4*)(SLX + ((size_t)b * TSEQ + t) * 1024 + ch0 + 8 * c8), xin[r]);
                    else {
#pragma unroll
                        for (int i = 0; i < 8; ++i) xin[r][i] = 0.f; }
                }
#pragma unroll
                for (int r = 0; r < 4; ++r) {
                    float y[8];
#pragma unroll
                    for (int i = 0; i < 8; ++i) y[i] = cbv[i] + xin[r][i] * cw[0][i] + xin[r + 1][i] * cw[1][i] + xin[r + 2][i] * cw[2][i] + xin[r + 3][i] * cw[3][i];
                    *(LAS u32x4*)(XC + (8 * tr + 4 * hh2 + r) * XS + 8 * c8) = (u32x4){pk2(y[0], y[1]), pk2(y[2], y[3]), pk2(y[4], y[5]), pk2(y[6], y[7])};
                }
            }
        } else {
#pragma unroll
            for (int r = 0; r < 4; ++r) {
                const int bs = 4 * tr + r;
                float y[8], lx[8];
                unpack8(*(const u32x4*)(SLX + (size_t)(MP + bs) * 1024 + ch0 + 8 * c8), lx);
                const float* cs = p.in[4] + (size_t)bs * 3 * 1024 + ch0 + 8 * c8;
#pragma unroll
                for (int i = 0; i < 8; ++i) y[i] = cbv[i] + cs[i] * cw[0][i] + cs[1024 + i] * cw[1][i] + cs[2048 + i] * cw[2][i] + lx[i] * cw[3][i];
                *(LAS u32x4*)(XC + bs * XS + 8 * c8) = (u32x4){pk2(y[0], y[1]), pk2(y[2], y[3]), pk2(y[4], y[5]), pk2(y[6], y[7])};
            }
        }
        }
        __syncthreads();
        {
        bf16x8 wb[2][2][4];
        {
            const bf16_t* WA = (const bf16_t*)(p.ws + WS_WLA) + (size_t)n * 16384; const bf16_t* WX = (const bf16_t*)(p.ws + WS_WLX) + (size_t)n * 16384;
#pragma unroll
            for (int nt = 0; nt < 2; ++nt)
#pragma unroll
                for (int ks = 0; ks < 4; ++ks) {
                    const int off = (32 * dq + 16 * nt + fr) * 128 + 32 * ks + 8 * fg;
                    wb[0][nt][ks] = *(const bf16x8*)(WA + off); wb[1][nt][ks] = *(const bf16x8*)(WX + off);
                }
        }
#pragma unroll
        for (int tt2 = 0; tt2 < 2; ++tt2) {
            const int tt = 2 * w + tt2;
            if (sample && tt >= 8) break;
            f32x4 acc[2][2];
#pragma unroll
            for (int m = 0; m < 2; ++m)
#pragma unroll
                for (int nt = 0; nt < 2; ++nt) acc[m][nt] = (f32x4){0.f, 0.f, 0.f, 0.f};
#pragma unroll
            for (int ks = 0; ks < 4; ++ks) {
                const bf16x8 a = *(const LAS bf16x8*)(XC + (16 * tt + fr) * XS + 32 * ks + 8 * fg);
#pragma unroll
                for (int m = 0; m < 2; ++m)
#pragma unroll
                    for (int nt = 0; nt < 2; ++nt) acc[m][nt] = __builtin_amdgcn_mfma_f32_16x16x32_bf16(a, wb[m][nt][ks], acc[m][nt], 0, 0, 0);
            }
#pragma unroll
            for (int nt = 0; nt < 2; ++nt)
#pragma unroll
                for (int j = 0; j < 4; ++j) {
                    RA[(16 * tt + 4 * fg + j) * RS + 16 * nt + fr] = acc[0][nt][j] + (nt ? bias_a1 : bias_a0);
                    IX[(16 * tt + 4 * fg + j) * RS + 16 * nt + fr] = acc[1][nt][j] + (nt ? bias_x1 : bias_x0);
                }
        }
        }
        __syncthreads();
        if (!sample) {
            float av[16], bv[16]; float Ap = 1.f, Hl = 0.f;
#pragma unroll
            for (int i = 0; i < 16; ++i) {
                const int tl = 16 * sub + i;
                const float ra = RA[tl * RS + sd], ix = IX[tl * RS + sd], xc = bf2f(XC[tl * XS + 32 * dq + sd]);
                const float la = -sp8 * sigm(ra);
                const float a = fexp(la);
                float mult = sqrtf(neg_expm1(2.0f * la));
                if (t0 + tl == 0) mult = 1.0f;
                const float bb = mult * sigm(ix) * xc;
                av[i] = a; bv[i] = bb; Hl = a * Hl + bb; Ap *= a;
            }
            COMP[sub * 32 + sd] = (f32x2){Ap, Hl};
            __syncthreads();
            float hin = hcar, hall = hcar;
#pragma unroll
            for (int s2 = 0; s2 < 16; ++s2) { const f32x2 cpp = COMP[s2 * 32 + sd]; hall = cpp.x * hall + cpp.y; if (s2 < sub) hin = hall; }
            hcar = hall;
            float hh = hin;
#pragma unroll
            for (int i = 0; i < 16; ++i) {
                hh = av[i] * hh + bv[i];
                const size_t off = ((size_t)b * TSEQ + t0 + 16 * sub + i) * 1024 + sch;
                BIN[off] = (bf16_t)f2bf(bf2f(SLY[off]) * hh);
            }
            if (tile == ntiles - 1 && sub == 15) p.out[O_LRUP + (size_t)b * 1024 + sch] = hh;
        } else {
#pragma unroll
            for (int i = 0; i < 8; ++i) {
                const int bs = 8 * sub + i;
                const float ra = RA[bs * RS + sd], ix = IX[bs * RS + sd], xc = bf2f(XC[bs * XS + 32 * dq + sd]);
                const float la = -sp8 * sigm(ra);
                const float a = fexp(la), mult = sqrtf(neg_expm1(2.0f * la));
                const float hh = a * p.in[3][(size_t)bs * 1024 + sch] + mult * sigm(ix) * xc;
                const size_t off = (size_t)(MP + bs) * 1024 + sch;
                BIN[off] = (bf16_t)f2bf(bf2f(SLY[off]) * hh);
                p.out[O_LRUS + (size_t)bs * 1024 + sch] = hh;
            }
        }
        __syncthreads();
    }
}
DI void phase_lru(const Params& p, LAS unsigned char* lds) {
    const int NI = 256 + 32;
    for (int it = blockIdx.x; it < NI; it += gridDim.x) {
        if (it < 256) lru_item(p, lds, false, it >> 5, (it >> 2) & 7, it & 3);
        else { const int r = it - 256; lru_item(p, lds, true, 0, r >> 2, r & 3); }
    }
}

constexpr int LDS_BYTES = 144 * 1024;
static_assert(HG_END <= LDS_BYTES && LR_END <= LDS_BYTES && pg8::STAGE_BYTES <= LDS_BYTES, "lds");

__global__ void __launch_bounds__(NTHREADS) fwd_kernel(Params p) {
    extern __shared__ __attribute__((aligned(16))) unsigned char lds_raw[];
    LAS unsigned char* lds = (LAS unsigned char*)lds_raw;
    cg::grid_group grid = cg::this_grid();
    const int lo = p.ph_lo, hi = p.ph_hi;
    unsigned char* ws = p.ws;
    bf16_t* SEG = (bf16_t*)(ws + WS_SEG);
    bf16_t* XN = (bf16_t*)p.out;
    const int G = gridDim.x, c = blockIdx.x;
    constexpr int NM = MT / 256;
#ifndef PHMASK
#define PHMASK 0x7ff
#endif
#define IN(k) (((PHMASK >> (k)) & 1) && lo <= (k) && (k) < hi)
#define SYNC(k) do { if (IN(k) && IN((k) + 1)) grid.sync(); } while (0)
    if (IN(0)) phase_prep(p, lds);
    SYNC(0);
    if (IN(1)) { pg8::Order S; S.init(NM, 16, G, c, 1024, XN, (const bf16_t*)(ws + WS_WIN));
        pg8::EpiProjH E{SEG, p.in[10]}; pg8::gemm_phase(lds, S, E); }
    SYNC(1);
    if (IN(2)) phase_hgrn(p, lds);
    SYNC(2);
    if (IN(3)) { pg8::Order S; S.init(NM, 16, G, c, 1024, XN, (const bf16_t*)(ws + WS_WIN) + (size_t)4096 * 1024);
        pg8::EpiProjL E{SEG, p.out}; pg8::gemm_phase(lds, S, E); }
    SYNC(3);
    if (IN(4)) phase_lru(p, lds);
    SYNC(4);
    if (IN(5)) { pg8::Order S; S.init(NM, 4, G, c, 1024, (const bf16_t*)(ws + WS_AIN), (const bf16_t*)(ws + WS_WPA), 2, (const bf16_t*)(ws + WS_BIN), (const bf16_t*)(ws + WS_WPB));
        pg8::EpiMerge E{SEG + (size_t)2 * MT * 1024, SEG + (size_t)3 * MT * 1024, SEG}; pg8::gemm_phase(lds, S, E); }
    SYNC(5);
    if (IN(6)) { pg8::Order S; S.init(NM, 4, G, c, 1024, SEG, (const bf16_t*)(ws + WS_WO));
        pg8::EpiF32 E{(float*)(SEG + (size_t)2 * MT * 1024)}; pg8::gemm_phase(lds, S, E); }
    SYNC(6);
    if (IN(7)) phase_r1(p, (const float*)(SEG + (size_t)2 * MT * 1024), SEG);
    SYNC(7);
    if (IN(8)) { pg8::Order S; S.init(NM, 22, G, c, 1024, SEG, (const bf16_t*)(ws + WS_WFI));
        pg8::EpiSwiGLU E{SEG + (size_t)MT * 1024}; pg8::gemm_phase(lds, S, E); }
    SYNC(8);
    if (IN(9)) { pg8::Order S; S.init(NM, 4, G, c, DFF, SEG + (size_t)MT * 1024, (const bf16_t*)(ws + WS_WFO));
        pg8::EpiF32 E{(float*)(ws + WS_AIN)}; pg8::gemm_phase(lds, S, E); }
    SYNC(9);
    if (IN(10)) phase_r2(p, (const float*)(ws + WS_AIN));
#undef IN
#undef SYNC
}

constexpr int NPHASES = 11;
#ifndef MK_PER_PHASE
#define MK_PER_PHASE 0
#endif

extern "C" void kernel_launch(void* const* d_in, const int* in_sizes, int n_in, void* d_out, int out_size, void* d_ws, size_t ws_size, hipStream_t stream) {
    static int grid = 0;
    if (grid == 0) {
        int dev = 0, cus = 0, per_cu = 0;
        hipGetDevice(&dev);
        hipDeviceGetAttribute(&cus, hipDeviceAttributeMultiprocessorCount, dev);
        hipFuncSetAttribute((const void*)fwd_kernel, hipFuncAttributeMaxDynamicSharedMemorySize, LDS_BYTES);
        hipOccupancyMaxActiveBlocksPerMultiprocessor(&per_cu, (const void*)fwd_kernel, NTHREADS, LDS_BYTES);
        if (per_cu < 1) per_cu = 1;
        grid = cus * per_cu;
        if (ws_size < WS_END) fprintf(stderr, "kernel_launch: workspace too small: %zu < %zu\n", ws_size, (size_t)WS_END);
        fprintf(stderr, "kernel_launch: cus %d per_cu %d grid %d ws %zu\n", cus, per_cu, grid, ws_size);
    }
    Params p{};
    for (int i = 0; i < 24; ++i) p.in[i] = (const float*)d_in[i];
    p.out = (float*)d_out; p.ws = (unsigned char*)d_ws;
#if MK_PER_PHASE
    for (int ph = 0; ph < NPHASES; ++ph) {
        p.ph_lo = ph; p.ph_hi = ph + 1;
        hipLaunchKernelGGL(fwd_kernel, dim3(grid), dim3(NTHREADS), LDS_BYTES, stream, p);
    }
#else
    p.ph_lo = 0; p.ph_hi = NPHASES;
    void* args[] = {&p};
    hipError_t e = hipLaunchCooperativeKernel((const void*)fwd_kernel, dim3(grid), dim3(NTHREADS), args, LDS_BYTES, stream);
    if (e != hipSuccess) fprintf(stderr, "cooperative launch failed: %s (grid %d)\n", hipGetErrorString(e), grid);
#endif
}
```

```cpp
#include <hip/hip_runtime.h>
#include <hip/hip_cooperative_groups.h>
#include <cstdio>
namespace cg = cooperative_groups;

#define LAS __attribute__((address_space(3)))
typedef unsigned short bf16_t;
typedef short bf16x8 __attribute__((ext_vector_type(8)));
typedef short s16x4 __attribute__((ext_vector_type(4)));
typedef float f32x4 __attribute__((ext_vector_type(4)));
typedef float f32x2 __attribute__((ext_vector_type(2)));
typedef unsigned u32x4 __attribute__((ext_vector_type(4)));
typedef unsigned u32x2 __attribute__((ext_vector_type(2)));
#define DI __device__ __forceinline__

constexpr int MP = 16384, MS = 128, MR = MP + MS, MT = 16640;
constexpr int DM = 1024, TSEQ = 2048, NBATCH = 8, DFF = 2816, NFI = 5632;
constexpr float EPS = 1e-6f;
constexpr int NTHREADS = 512;

constexpr size_t O_Y = 0, O_HGP = 16908288, O_LRUP = 17956864, O_CVP = 17965056, O_HGS = 17989632, O_LRUS = 34766848, O_CVS = 34897920;
constexpr size_t SEGB = (size_t)MT * 1024 * 2;
constexpr size_t WS_WIN = 0;
constexpr size_t WS_WPA = WS_WIN + (size_t)8192 * 1024 * 2;
constexpr size_t WS_WPB = WS_WPA + (size_t)1024 * 1024 * 2;
constexpr size_t WS_WO  = WS_WPB + (size_t)1024 * 1024 * 2;
constexpr size_t WS_WFI = WS_WO + (size_t)1024 * 1024 * 2;
constexpr size_t WS_WFO = WS_WFI + (size_t)NFI * 1024 * 2;
constexpr size_t WS_WLA = WS_WFO + (size_t)1024 * DFF * 2;
constexpr size_t WS_WLX = WS_WLA + (size_t)8 * 128 * 128 * 2;
constexpr size_t WS_SEG = WS_WLX + (size_t)8 * 128 * 128 * 2;
constexpr size_t WS_AIN = WS_SEG + 4 * SEGB;
constexpr size_t WS_BIN = WS_AIN + SEGB;
constexpr size_t WS_BAR = WS_BIN + SEGB;
constexpr size_t WS_END = WS_BAR + 16384;
static_assert(WS_END <= (size_t)256 * 1024 * 1024, "workspace");

struct Params { const float* in[24]; float* out; unsigned char* ws; int ph_lo, ph_hi; };

DI unsigned f2bf(float f) { unsigned u = __builtin_bit_cast(unsigned, f); return (u + 0x7fffu + ((u >> 16) & 1u)) >> 16; }
DI unsigned pk2(float lo, float hi) { return f2bf(lo) | (f2bf(hi) << 16); }
DI float bf2f(unsigned short b) { return __builtin_bit_cast(float, ((unsigned)b) << 16); }
DI float bflo(unsigned w) { return __builtin_bit_cast(float, w << 16); }
DI float bfhi(unsigned w) { return __builtin_bit_cast(float, w & 0xffff0000u); }
DI float fexp(float x) { return __expf(x); }
DI float frcp(float x) { return __builtin_amdgcn_rcpf(x); }
DI float sigm(float x) { return frcp(1.0f + fexp(-x)); }
DI float silu(float x) { return x * sigm(x); }
DI float gelu_tanh(float x) { const float u = 1.5957691216f * (x + 0.044715f * x * x * x); return x * sigm(u); }
DI float wave_sum(float v) {
#pragma unroll
    for (int o = 1; o < 64; o <<= 1) v += __shfl_xor(v, o);
    return v;
}
DI u32x4 pack8(const f32x4& a, const f32x4& b) { u32x4 w; w.x = pk2(a[0], a[1]); w.y = pk2(a[2], a[3]); w.z = pk2(b[0], b[1]); w.w = pk2(b[2], b[3]); return w; }
DI void unpack8(const u32x4& w, float (&f)[8]) { f[0] = bflo(w.x); f[1] = bfhi(w.x); f[2] = bflo(w.y); f[3] = bfhi(w.y); f[4] = bflo(w.z); f[5] = bfhi(w.z); f[6] = bflo(w.w); f[7] = bfhi(w.w); }


#define XB_TMO      128
#define XB_XCNT(j)  (256  + 64 * (j))
#define XB_XSUB(j)  (1280 + 64 * (j))
#define XB_XGEN(j)  (2304 + 64 * (j))
#define XB_TOP      3328
#define XB_TOPGEN   3392
#define XCD_BAR_WORDS 3456
#define XB_SPIN_CAP (1u << 18)
DI unsigned xb_ld(unsigned* p)              { return __hip_atomic_load(p, __ATOMIC_RELAXED, __HIP_MEMORY_SCOPE_AGENT); }
DI unsigned xb_add(unsigned* p, unsigned v) { return __hip_atomic_fetch_add(p, v, __ATOMIC_RELAXED, __HIP_MEMORY_SCOPE_AGENT); }
DI unsigned xb_xcc_id() { return (unsigned)__builtin_amdgcn_s_getreg((3 << 11) | 20) & 0xFu; }
#define XB_SPIN(cond, bar) do { unsigned _sp = 0; while (cond) { __builtin_amdgcn_s_sleep(1); \
    if ((++_sp & 255u) == 0u) { if (xb_ld(&(bar)[XB_TMO])) break; if (_sp > XB_SPIN_CAP) { atomicAdd(&(bar)[XB_TMO], 1u); break; } } } } while (0)
struct XcdBarrier { unsigned* bar; unsigned x; volatile LAS unsigned* st; };
DI XcdBarrier xcd_barrier_post(unsigned* bar, volatile LAS unsigned* st) {
    XcdBarrier b; b.bar = bar; b.x = xb_xcc_id(); b.st = st;
    if (threadIdx.x == 0) (void)xb_add(&bar[XB_XCNT(b.x)], 1u);
    return b;
}
DI void xcd_barrier_complete(unsigned* bar, unsigned x, unsigned& nloc, unsigned& nx) {
    const unsigned G = gridDim.x * gridDim.y * gridDim.z;
    unsigned sum, cnt, mine, sp = 0u;
    for (;;) {
        sum = 0u; cnt = 0u; mine = 0u;
#pragma unroll
        for (unsigned j = 0; j < 16; ++j) { const unsigned c = xb_ld(&bar[XB_XCNT(j)]); sum += c; cnt += (c > 0u) ? 1u : 0u; mine = (j == x) ? c : mine; }
        if (sum == G) break;
        __builtin_amdgcn_s_sleep(1);
        if ((++sp & 255u) == 0u) { if (xb_ld(&bar[XB_TMO])) break; if (sp > XB_SPIN_CAP) { atomicAdd(&bar[XB_TMO], 1u); break; } }
    }
    nloc = mine > 0u ? mine : 1u; nx = cnt > 0u ? cnt : 1u;
}
DI void xcd_barrier(const XcdBarrier& b) {
    asm volatile("s_waitcnt vmcnt(0)" ::: "memory");
    __syncthreads();
    if (threadIdx.x == 0) {
        unsigned* bar = b.bar;
        __builtin_amdgcn_s_waitcnt(0);
        unsigned nloc = b.st[0], nx = b.st[1];
        if (nloc == 0u) { xcd_barrier_complete(bar, b.x, nloc, nx); b.st[0] = nloc; b.st[1] = nx; }
        const unsigned old = xb_add(&bar[XB_XSUB(b.x)], 1u);
        const unsigned gen = old / nloc;
        if (old + 1u == (gen + 1u) * nloc) {
            __builtin_amdgcn_fence(__ATOMIC_RELEASE, "agent");
            asm volatile("s_waitcnt vmcnt(0)" ::: "memory");
            const unsigned og = xb_add(&bar[XB_TOP], 1u);
            const unsigned tg = og / nx;
            if (og + 1u == (tg + 1u) * nx) xb_add(&bar[XB_TOPGEN], 1u);
            else XB_SPIN(xb_ld(&bar[XB_TOPGEN]) == tg, bar);
            __builtin_amdgcn_fence(__ATOMIC_ACQUIRE, "agent");
            xb_add(&bar[XB_XGEN(b.x)], 1u);
            asm volatile("s_waitcnt vmcnt(0)" ::: "memory");
        } else {
            XB_SPIN(xb_ld(&bar[XB_XGEN(b.x)]) == gen, bar);
            __builtin_amdgcn_fence(__ATOMIC_ACQUIRE, "agent");
            asm volatile("s_waitcnt vmcnt(0)" ::: "memory");
        }
    }
    __syncthreads();
}

namespace pg8 {
constexpr int BM = 256, BK = 64, HALF = 128, HTB = HALF * BK * 2, STAGE_BYTES = 8 * HTB, NXCD = 8, WGM = 8;
DI int lds_byte(int r, int c) { const int st = (r >> 4) * 2 + (c >> 5), rr = r & 15, cc = c & 31, ob = rr * 64 + cc * 2; return st * 1024 + (ob ^ (((ob >> 9) & 1) << 5)); }
DI void stage_rc(int b, int& R, int& C) { const int st = b / 1024, sb = b % 1024, swz = sb ^ (((sb >> 9) & 1) << 5); R = (st >> 1) * 16 + swz / 64; C = (st & 1) * 32 + (swz % 64) / 2; }
DI int perm32(int rho) { const int n = rho >> 4, i = rho & 15; return 8 * (i >> 2) + 4 * n + (i & 3); }

struct Unit { int pm, pn, part; };
struct Order {
    int nM, nN, nwg, G, c, parts, K;
    const bf16_t *A0, *A1, *B0, *B1;
    DI void init(int nM_, int nN_, int G_, int c_, int K_, const bf16_t* a0, const bf16_t* b0, int parts_ = 1, const bf16_t* a1 = nullptr, const bf16_t* b1 = nullptr) {
        nM = nM_; nN = nN_; nwg = nM * nN; G = G_; c = c_; K = K_; parts = parts_; A0 = a0; B0 = b0; A1 = a1; B1 = b1; }
    DI bool next(int i, Unit& u) const {
        const int ti = (parts == 2) ? (i >> 1) : i; u.part = (parts == 2) ? (i & 1) : 0;
        const long L = (long)ti * G + c; if (L >= nwg) return false;
        int wgid = (int)L; { const int q = nwg / NXCD, r = nwg % NXCD, xcd = wgid % NXCD, off = wgid / NXCD; wgid = (xcd < r ? xcd * (q + 1) : r * (q + 1) + (xcd - r) * q) + off; }
        const int nig = WGM * nN, gid = wgid / nig, fm = gid * WGM, gsz = (nM - fm) < WGM ? (nM - fm) : WGM;
        u.pm = fm + ((wgid % nig) % gsz); u.pn = (wgid % nig) / gsz; return true;
    }
    DI const char* pa(const Unit& u) const { return (const char*)(u.part ? A1 : A0) + (size_t)u.pm * BM * K * 2; }
    DI const char* pb(const Unit& u) const { return (const char*)(u.part ? B1 : B0) + (size_t)u.pn * BM * K * 2; }
};

template <class Epi>
__device__ __forceinline__ void gemm_phase(LAS unsigned char* lds, const Order& S, const Epi& E) {
    const int tid = threadIdx.x, wid = __builtin_amdgcn_readfirstlane(tid >> 6), lane = tid & 63, wr = wid >> 2, wc = wid & 3, fr = lane & 15, fq = lane >> 4;
    const int K = S.K, nt = K / BK;
    unsigned voffA[2], voffB[2];
#pragma unroll
    for (int i = 0; i < 2; ++i) { int R, C; stage_rc(tid * 16 + i * 8192, R, C); const int Rb = (R & ~31) + perm32(R & 31);
        voffA[i] = (unsigned)(R * K + C) * 2u; voffB[i] = (unsigned)(Rb * K + C) * 2u; }
    const size_t kstep = (size_t)(BK * 2);
    const size_t hstep = (size_t)HALF * K * 2;
    const unsigned ldsw = (unsigned)wid * 1024u;
    const int aoff = lds_byte(wr * 64 + fr, fq * 8), boff = lds_byte(wc * 32 + fr, fq * 8);
#define PG8_SA(b, h) (((b) * 2 + (h)) * HTB)
#define PG8_SB(b, h) ((4 + (b) * 2 + (h)) * HTB)
#define PG8_STAGE(bufoff, gbase, voff) do { _Pragma("unroll") for (int _i = 0; _i < 2; ++_i) \
        __builtin_amdgcn_global_load_lds((const unsigned*)((const char*)(gbase) + (voff)[_i]), (LAS unsigned*)(lds + (bufoff) + ldsw + _i * 8192), 16, 0, 0); } while (0)
#define PG8_LDA(dst, b, h) do { _Pragma("unroll") for (int m = 0; m < 4; ++m) _Pragma("unroll") for (int k = 0; k < 2; ++k) dst[m][k] = *(const LAS bf16x8*)(lds + PG8_SA(b, h) + aoff + m * 2048 + k * 1024); } while (0)
#define PG8_LDB(dst, b, h) do { _Pragma("unroll") for (int n = 0; n < 2; ++n) _Pragma("unroll") for (int k = 0; k < 2; ++k) dst[n][k] = *(const LAS bf16x8*)(lds + PG8_SB(b, h) + boff + n * 2048 + k * 1024); } while (0)
#define PG8_MMA(ai, bj, At, Bt) do { __builtin_amdgcn_s_setprio(1); _Pragma("unroll") for (int m = 0; m < 4; ++m) _Pragma("unroll") for (int n = 0; n < 2; ++n) _Pragma("unroll") for (int k = 0; k < 2; ++k) \
        acc[ai][bj][m][n] = __builtin_amdgcn_mfma_f32_16x16x32_bf16(Bt[n][k], At[m][k], acc[ai][bj][m][n], 0, 0, 0); __builtin_amdgcn_s_setprio(0); } while (0)
#define PG8_WAIT_V(n) asm volatile("s_waitcnt vmcnt(" #n ")" ::: "memory")
#define PG8_WAIT_L(n) asm volatile("s_waitcnt lgkmcnt(" #n ")" ::: "memory")
#define PG8_BAR __builtin_amdgcn_s_barrier()
#define PG8_SCHED __builtin_amdgcn_sched_barrier(0)
    Unit cur, nxt; int ui = 0;
    if (!S.next(0, cur)) return;
    f32x4 acc[2][2][4][2];
#pragma unroll
    for (int a = 0; a < 2; ++a)
#pragma unroll
        for (int b = 0; b < 2; ++b)
#pragma unroll
            for (int m = 0; m < 4; ++m)
#pragma unroll
                for (int n = 0; n < 2; ++n) acc[a][b][m][n] = (f32x4){0.f, 0.f, 0.f, 0.f};
    bf16x8 At[4][2], B0[2][2], B1[2][2];
    const char* cA = S.pa(cur); const char* cB = S.pb(cur);
    PG8_STAGE(PG8_SB(0, 0), cB, voffB); PG8_STAGE(PG8_SA(0, 0), cA, voffA); PG8_STAGE(PG8_SB(0, 1), cB + hstep, voffB); PG8_STAGE(PG8_SA(0, 1), cA + hstep, voffA);
    if (wr == 1) PG8_BAR;
    PG8_WAIT_V(4); PG8_BAR;
    PG8_STAGE(PG8_SB(1, 0), cB + kstep, voffB); PG8_STAGE(PG8_SA(1, 0), cA + kstep, voffA); PG8_STAGE(PG8_SB(1, 1), cB + hstep + kstep, voffB);
    PG8_WAIT_V(6); PG8_BAR;
    for (;;) {
        const bool has_next = S.next(ui + 1, nxt);
        const char* nA = has_next ? S.pa(nxt) : cA; const char* nB = has_next ? S.pb(nxt) : cB;
        for (int t = 0; t < nt; t += 2) {
            const bool last = (t == nt - 2);
            const char* a1 = cA + (size_t)(t + 1) * kstep;
            const char* a2 = last ? nA : cA + (size_t)(t + 2) * kstep; const char* b2 = last ? nB : cB + (size_t)(t + 2) * kstep;
            const char* a3 = a2 + kstep; const char* b3 = b2 + kstep;
            PG8_LDB(B0, 0, 0); PG8_SCHED; PG8_LDA(At, 0, 0); PG8_STAGE(PG8_SA(1, 1), a1 + hstep, voffA);
            PG8_WAIT_L(8); PG8_BAR; PG8_WAIT_L(0); PG8_MMA(0, 0, At, B0); PG8_BAR; PG8_SCHED;
            PG8_LDB(B1, 0, 1); PG8_STAGE(PG8_SB(0, 0), b2, voffB);
            PG8_BAR; PG8_WAIT_L(0); PG8_MMA(0, 1, At, B1); PG8_BAR;
            PG8_LDA(At, 0, 1); PG8_STAGE(PG8_SA(0, 0), a2, voffA);
            PG8_BAR; PG8_WAIT_L(0); PG8_MMA(1, 0, At, B0); PG8_BAR; PG8_SCHED;
            PG8_STAGE(PG8_SB(0, 1), b2 + hstep, voffB);
            PG8_WAIT_V(6); PG8_BAR; PG8_MMA(1, 1, At, B1); PG8_BAR;
            PG8_LDB(B0, 1, 0); PG8_SCHED; PG8_LDA(At, 1, 0); PG8_STAGE(PG8_SA(0, 1), a2 + hstep, voffA);
            PG8_WAIT_L(8); PG8_BAR; PG8_WAIT_L(0); PG8_MMA(0, 0, At, B0); PG8_BAR; PG8_SCHED;
            PG8_LDB(B1, 1, 1); PG8_STAGE(PG8_SB(1, 0), b3, voffB);
            PG8_BAR; PG8_WAIT_L(0); PG8_MMA(0, 1, At, B1); PG8_BAR;
            PG8_LDA(At, 1, 1); PG8_STAGE(PG8_SA(1, 0), a3, voffA);
            PG8_BAR; PG8_WAIT_L(0); PG8_MMA(1, 0, At, B0); PG8_BAR; PG8_SCHED;
            PG8_STAGE(PG8_SB(1, 1), b3 + hstep, voffB);
            PG8_WAIT_V(6); PG8_BAR; PG8_MMA(1, 1, At, B1); PG8_BAR;
        }
        E(acc, cur, wr, wc, fr, fq);
        if (!has_next) break;
        if (!E.keep(cur)) {
#pragma unroll
            for (int a = 0; a < 2; ++a)
#pragma unroll
                for (int b = 0; b < 2; ++b)
#pragma unroll
                    for (int m = 0; m < 4; ++m)
#pragma unroll
                        for (int n = 0; n < 2; ++n) acc[a][b][m][n] = (f32x4){0.f, 0.f, 0.f, 0.f};
        }
        cur = nxt; cA = nA; cB = nB; ++ui;
    }
    PG8_WAIT_V(0);
    if (wr == 0) PG8_BAR;
    PG8_BAR;
#undef PG8_SA
#undef PG8_SB
#undef PG8_STAGE
#undef PG8_LDA
#undef PG8_LDB
#undef PG8_MMA
#undef PG8_WAIT_V
#undef PG8_WAIT_L
#undef PG8_BAR
#undef PG8_SCHED
}

typedef f32x4 Acc[2][2][4][2];
struct EpiProjH {
    bf16_t* seg; const float* lbl;
    DI bool keep(const Unit&) const { return false; }
    DI void operator()(Acc& acc, const Unit& u, int wr, int wc, int fr, int fq) const {
        const int colt = u.pn * BM, sg = colt >> 10, cb = (colt & 1023) + wc * 32 + 8 * fq;
        bf16_t* base = seg + (size_t)sg * MT * 1024;
#pragma unroll
        for (int bj = 0; bj < 2; ++bj) {
            const int c0 = cb + bj * HALF;
            float lb[8];
            if (sg == 1) {
#pragma unroll
                for (int j = 0; j < 8; ++j) lb[j] = sigm(lbl[c0 + j] - lbl[1024 + c0 + j]);
            }
#pragma unroll
            for (int ai = 0; ai < 2; ++ai)
#pragma unroll
                for (int m = 0; m < 4; ++m) {
                    const int row = u.pm * BM + wr * 64 + fr + ai * HALF + m * 16;
                    float v[8];
#pragma unroll
                    for (int j = 0; j < 4; ++j) { v[j] = acc[ai][bj][m][0][j]; v[4 + j] = acc[ai][bj][m][1][j]; }
                    if (sg == 0 || sg == 3) {
#pragma unroll
                        for (int j = 0; j < 8; ++j) v[j] = silu(v[j]);
                    } else if (sg == 1) {
#pragma unroll
                        for (int j = 0; j < 8; ++j) v[j] = __logf(lb[j] + (1.0f - lb[j]) * sigm(v[j]));
                    }
                    u32x4 w; w.x = pk2(v[0], v[1]); w.y = pk2(v[2], v[3]); w.z = pk2(v[4], v[5]); w.w = pk2(v[6], v[7]);
                    *(u32x4*)(base + (size_t)row * 1024 + c0) = w;
                }
        }
    }
};
struct EpiProjL {
    bf16_t* seg; float* out;
    DI bool keep(const Unit&) const { return false; }
    DI void operator()(Acc& acc, const Unit& u, int wr, int wc, int fr, int fq) const {
        const int colt = u.pn * BM, sg = colt >> 10, cb = (colt & 1023) + wc * 32 + 8 * fq;
        bf16_t* base = seg + (size_t)sg * MT * 1024;
#pragma unroll
        for (int bj = 0; bj < 2; ++bj) {
            const int c0 = cb + bj * HALF;
#pragma unroll
            for (int ai = 0; ai < 2; ++ai)
#pragma unroll
                for (int m = 0; m < 4; ++m) {
                    const int row = u.pm * BM + wr * 64 + fr + ai * HALF + m * 16;
                    float v[8];
#pragma unroll
                    for (int j = 0; j < 4; ++j) { v[j] = acc[ai][bj][m][0][j]; v[4 + j] = acc[ai][bj][m][1][j]; }
                    if (sg == 0) {
                        float* dst = nullptr;
                        if (row < MP) { const int t = row & (TSEQ - 1); if (t >= TSEQ - 3) dst = out + O_CVP + ((size_t)(row >> 11) * 3 + (t - (TSEQ - 3))) * 1024 + c0; }
                        else if (row < MR) dst = out + O_CVS + ((size_t)(row - MP) * 3 + 2) * 1024 + c0;
                        if (dst) { *(f32x4*)dst = acc[ai][bj][m][0]; *(f32x4*)(dst + 4) = acc[ai][bj][m][1]; }
                    } else if (sg == 1) {
#pragma unroll
                        for (int j = 0; j < 8; ++j) v[j] = gelu_tanh(v[j]);
                    } else {
#pragma unroll
                        for (int j = 0; j < 8; ++j) v[j] = sigm(v[j]);
                    }
                    u32x4 w; w.x = pk2(v[0], v[1]); w.y = pk2(v[2], v[3]); w.z = pk2(v[4], v[5]); w.w = pk2(v[6], v[7]);
                    *(u32x4*)(base + (size_t)row * 1024 + c0) = w;
                }
        }
    }
};
struct EpiMerge {
    const bf16_t *sga, *sgb; bf16_t* dst;
    DI bool keep(const Unit& u) const { return u.part == 0; }
    DI void operator()(Acc& acc, const Unit& u, int wr, int wc, int fr, int fq) const {
#pragma unroll
        for (int bj = 0; bj < 2; ++bj) {
            const int c0 = u.pn * BM + wc * 32 + 8 * fq + bj * HALF;
#pragma unroll
            for (int ai = 0; ai < 2; ++ai)
#pragma unroll
                for (int m = 0; m < 4; ++m) {
                    const int row = u.pm * BM + wr * 64 + fr + ai * HALF + m * 16;
                    const size_t off = (size_t)row * 1024 + c0;
                    float gb[8]; unpack8(*(const u32x4*)(sgb + off), gb);
                    if (u.part == 0) {
                        float ga[8]; unpack8(*(const u32x4*)(sga + off), ga);
#pragma unroll
                        for (int j = 0; j < 4; ++j) { acc[ai][bj][m][0][j] *= ga[j] * frcp(gb[j]); acc[ai][bj][m][1][j] *= ga[4 + j] * frcp(gb[4 + j]); }
                    } else {
                        float v[8];
#pragma unroll
                        for (int j = 0; j < 4; ++j) { v[j] = acc[ai][bj][m][0][j] * gb[j]; v[4 + j] = acc[ai][bj][m][1][j] * gb[4 + j]; }
                        u32x4 w; w.x = pk2(v[0], v[1]); w.y = pk2(v[2], v[3]); w.z = pk2(v[4], v[5]); w.w = pk2(v[6], v[7]);
                        *(u32x4*)(dst + off) = w;
                    }
                }
        }
    }
};
struct EpiF32 {
    float* C;
    DI bool keep(const Unit&) const { return false; }
    DI void operator()(Acc& acc, const Unit& u, int wr, int wc, int fr, int fq) const {
#pragma unroll
        for (int bj = 0; bj < 2; ++bj) {
            const int c0 = u.pn * BM + wc * 32 + 8 * fq + bj * HALF;
#pragma unroll
            for (int ai = 0; ai < 2; ++ai)
#pragma unroll
                for (int m = 0; m < 4; ++m) {
                    const int row = u.pm * BM + wr * 64 + fr + ai * HALF + m * 16;
                    float* p = C + (size_t)row * 1024 + c0;
                    *(f32x4*)p = acc[ai][bj][m][0]; *(f32x4*)(p + 4) = acc[ai][bj][m][1];
                }
        }
    }
};
struct EpiSwiGLU {
    bf16_t* act;
    DI bool keep(const Unit&) const { return false; }
    DI void operator()(Acc& acc, const Unit& u, int wr, int wc, int fr, int fq) const {
        const int c0 = u.pn * HALF + wc * 32 + 8 * fq;
#pragma unroll
        for (int ai = 0; ai < 2; ++ai)
#pragma unroll
            for (int m = 0; m < 4; ++m) {
                const int row = u.pm * BM + wr * 64 + fr + ai * HALF + m * 16;
                float v[8];
#pragma unroll
                for (int j = 0; j < 4; ++j) { v[j] = silu(acc[ai][0][m][0][j]) * acc[ai][1][m][0][j]; v[4 + j] = silu(acc[ai][0][m][1][j]) * acc[ai][1][m][1][j]; }
                u32x4 w; w.x = pk2(v[0], v[1]); w.y = pk2(v[2], v[3]); w.z = pk2(v[4], v[5]); w.w = pk2(v[6], v[7]);
                *(u32x4*)(act + (size_t)row * DFF + c0) = w;
            }
    }
};
}


constexpr int RED_STRIDE = 68, RED_WAVE = 16 * RED_STRIDE, RED_BYTES = 8 * RED_WAVE * 4;
template <int NT>
DI void skinny_core(const bf16_t* A, int lda, const bf16_t* const (&B)[NT], int ldb, int K, LAS float* RED) {
    const int tid = threadIdx.x, lane = tid & 63, w = tid >> 6, fr = lane & 15, fg = lane >> 4;
    f32x4 acc[NT];
#pragma unroll
    for (int nt = 0; nt < NT; ++nt) acc[nt] = (f32x4){0.f, 0.f, 0.f, 0.f};
    const int nper = K >> 8;
    const bf16_t* ap = A + (size_t)fr * lda + 8 * fg + 32 * w;
    const bf16_t* bp[NT];
#pragma unroll
    for (int nt = 0; nt < NT; ++nt) bp[nt] = B[nt] + (size_t)fr * ldb + 8 * fg + 32 * w;
    for (int i0 = 0; i0 < nper; i0 += 4) {
        bf16x8 a[4], b[4][NT];
#pragma unroll
        for (int u = 0; u < 4; ++u) if (i0 + u < nper) {
            a[u] = *(const bf16x8*)(ap + (size_t)(i0 + u) * 256);
#pragma unroll
            for (int nt = 0; nt < NT; ++nt) b[u][nt] = *(const bf16x8*)(bp[nt] + (size_t)(i0 + u) * 256);
        }
#pragma unroll
        for (int u = 0; u < 4; ++u) if (i0 + u < nper) {
#pragma unroll
            for (int nt = 0; nt < NT; ++nt) acc[nt] = __builtin_amdgcn_mfma_f32_16x16x32_bf16(a[u], b[u][nt], acc[nt], 0, 0, 0);
        }
    }
#pragma unroll
    for (int nt = 0; nt < NT; ++nt)
#pragma unroll
        for (int j = 0; j < 4; ++j) RED[w * RED_WAVE + (4 * fg + j) * RED_STRIDE + 16 * nt + fr] = acc[nt][j];
}
DI void skinny_reduce(const LAS float* RED, int row, int col0, float (&v)[8]) {
#pragma unroll
    for (int j = 0; j < 8; ++j) v[j] = 0.f;
#pragma unroll
    for (int w = 0; w < 8; ++w) {
        const f32x4 a = *(const LAS f32x4*)(RED + w * RED_WAVE + row * RED_STRIDE + col0), b = *(const LAS f32x4*)(RED + w * RED_WAVE + row * RED_STRIDE + col0 + 4);
        v[0] += a.x; v[1] += a.y; v[2] += a.z; v[3] += a.w; v[4] += b.x; v[5] += b.y; v[6] += b.z; v[7] += b.w;
    }
}
DI void store8_bf16(bf16_t* dst, const float (&v)[8]) { *(u32x4*)dst = (u32x4){pk2(v[0], v[1]), pk2(v[2], v[3]), pk2(v[4], v[5]), pk2(v[6], v[7])}; }

DI void skinny_proj(const Params& p, LAS unsigned char* lds, int half) {
    LAS float* RED = (LAS float*)lds;
    const bf16_t* XN = (const bf16_t*)p.out + (size_t)MP * 1024;
    const bf16_t* WT = (const bf16_t*)(p.ws + WS_WIN) + (size_t)half * 4096 * 1024;
    bf16_t* SEG = (bf16_t*)(p.ws + WS_SEG);
    const int tid = threadIdx.x;
    for (int u = blockIdx.x; u < 512; u += gridDim.x) {
        const int rt = u & 7, ct = u >> 3;
        const bf16_t* B[4] = {WT + (size_t)(64 * ct) * 1024, WT + (size_t)(64 * ct + 16) * 1024, WT + (size_t)(64 * ct + 32) * 1024, WT + (size_t)(64 * ct + 48) * 1024};
        skinny_core<4>(XN + (size_t)(16 * rt) * 1024, 1024, B, 1024, 1024, RED);
        __syncthreads();
        if (tid < 128) {
            const int r = tid >> 3, c8 = tid & 7, bs = 16 * rt + r, row = MP + bs, col = 64 * ct + 8 * c8, sg = col >> 10, cc = col & 1023;
            float v[8]; skinny_reduce(RED, r, 8 * c8, v);
            if (half == 0) {
                if (sg == 0 || sg == 3) {
#pragma unroll
                    for (int j = 0; j < 8; ++j) v[j] = silu(v[j]);
                } else if (sg == 1) {
#pragma unroll
                    for (int j = 0; j < 8; ++j) { const float lb = sigm(p.in[10][cc + j] - p.in[10][1024 + cc + j]); v[j] = __logf(lb + (1.0f - lb) * sigm(v[j])); }
                }
            } else {
                if (sg == 0) { float* dst = p.out + O_CVS + ((size_t)bs * 3 + 2) * 1024 + cc; *(f32x4*)dst = (f32x4){v[0], v[1], v[2], v[3]}; *(f32x4*)(dst + 4) = (f32x4){v[4], v[5], v[6], v[7]}; }
                else if (sg == 1) {
#pragma unroll
                    for (int j = 0; j < 8; ++j) v[j] = gelu_tanh(v[j]);
                } else {
#pragma unroll
                    for (int j = 0; j < 8; ++j) v[j] = sigm(v[j]);
                }
            }
            store8_bf16(SEG + (size_t)sg * MT * 1024 + (size_t)row * 1024 + cc, v);
        }
        __syncthreads();
    }
}
DI void skinny_merge(const Params& p, LAS unsigned char* lds) {
    LAS float* RED0 = (LAS float*)lds; LAS float* RED1 = (LAS float*)(lds + RED_BYTES);
    bf16_t* SEG = (bf16_t*)(p.ws + WS_SEG);
    const bf16_t* AIN = (const bf16_t*)(p.ws + WS_AIN) + (size_t)MP * 1024; const bf16_t* BIN = (const bf16_t*)(p.ws + WS_BIN) + (size_t)MP * 1024;
    const bf16_t* WA = (const bf16_t*)(p.ws + WS_WPA); const bf16_t* WB = (const bf16_t*)(p.ws + WS_WPB);
    const int tid = threadIdx.x;
    for (int u = blockIdx.x; u < 128; u += gridDim.x) {
        const int rt = u & 7, ct = u >> 3;
        { const bf16_t* B[4] = {WA + (size_t)(64 * ct) * 1024, WA + (size_t)(64 * ct + 16) * 1024, WA + (size_t)(64 * ct + 32) * 1024, WA + (size_t)(64 * ct + 48) * 1024};
          skinny_core<4>(AIN + (size_t)(16 * rt) * 1024, 1024, B, 1024, 1024, RED0); }
        { const bf16_t* B[4] = {WB + (size_t)(64 * ct) * 1024, WB + (size_t)(64 * ct + 16) * 1024, WB + (size_t)(64 * ct + 32) * 1024, WB + (size_t)(64 * ct + 48) * 1024};
          skinny_core<4>(BIN + (size_t)(16 * rt) * 1024, 1024, B, 1024, 1024, RED1); }
        __syncthreads();
        if (tid < 128) {
            const int r = tid >> 3, c8 = tid & 7, row = MP + 16 * rt + r, col = 64 * ct + 8 * c8;
            float va[8], vb[8], ga[8], gb[8]; skinny_reduce(RED0, r, 8 * c8, va); skinny_reduce(RED1, r, 8 * c8, vb);
            const size_t off = (size_t)row * 1024 + col;
            unpack8(*(const u32x4*)(SEG + (size_t)2 * MT * 1024 + off), ga); unpack8(*(const u32x4*)(SEG + (size_t)3 * MT * 1024 + off), gb);
#pragma unroll
            for (int j = 0; j < 8; ++j) va[j] = ga[j] * va[j] + gb[j] * vb[j];
            store8_bf16(SEG + off, va);
        }
        __syncthreads();
    }
}
DI void skinny_f32(LAS unsigned char* lds, const bf16_t* A, int K, const bf16_t* Bt, float* C) {
    LAS float* RED = (LAS float*)lds;
    const int tid = threadIdx.x;
    for (int u = blockIdx.x; u < 128; u += gridDim.x) {
        const int rt = u & 7, ct = u >> 3;
        const bf16_t* B[4] = {Bt + (size_t)(64 * ct) * K, Bt + (size_t)(64 * ct + 16) * K, Bt + (size_t)(64 * ct + 32) * K, Bt + (size_t)(64 * ct + 48) * K};
        skinny_core<4>(A + (size_t)(MP + 16 * rt) * K, K, B, K, K, RED);
        __syncthreads();
        if (tid < 128) {
            const int r = tid >> 3, c8 = tid & 7, row = MP + 16 * rt + r, col = 64 * ct + 8 * c8;
            float v[8]; skinny_reduce(RED, r, 8 * c8, v);
            float* dst = C + (size_t)row * 1024 + col; *(f32x4*)dst = (f32x4){v[0], v[1], v[2], v[3]}; *(f32x4*)(dst + 4) = (f32x4){v[4], v[5], v[6], v[7]};
        }
        __syncthreads();
    }
}
DI void skinny_swiglu(const Params& p, LAS unsigned char* lds) {
    LAS float* RED = (LAS float*)lds;
    bf16_t* SEG = (bf16_t*)(p.ws + WS_SEG);
    const bf16_t* HN = SEG + (size_t)MP * 1024; const bf16_t* WT = (const bf16_t*)(p.ws + WS_WFI); bf16_t* ACT = SEG + (size_t)MT * 1024;
    const int tid = threadIdx.x;
    int u0, ustep;
    if (gridDim.x == 256) { u0 = (int)blockIdx.x - 128; ustep = 128; } else { u0 = blockIdx.x; ustep = gridDim.x; }
    if (u0 < 0) return;
    for (int u = u0; u < 704; u += ustep) {
        const int rt = u & 7, cg = u >> 3, pn = cg >> 2, j0 = 32 * (cg & 3);
        const bf16_t* B[4] = {WT + (size_t)(256 * pn + j0) * 1024, WT + (size_t)(256 * pn + j0 + 16) * 1024, WT + (size_t)(256 * pn + 128 + j0) * 1024, WT + (size_t)(256 * pn + 128 + j0 + 16) * 1024};
        skinny_core<4>(HN + (size_t)(16 * rt) * 1024, 1024, B, 1024, 1024, RED);
        __syncthreads();
        if (tid < 64) {
            const int r = tid >> 2, c8 = tid & 3, row = MP + 16 * rt + r;
            float g[8], up[8]; skinny_reduce(RED, r, 8 * c8, g); skinny_reduce(RED, r, 32 + 8 * c8, up);
#pragma unroll
            for (int j = 0; j < 8; ++j) g[j] = silu(g[j]) * up[j];
            store8_bf16(ACT + (size_t)row * DFF + 128 * pn + j0 + 8 * c8, g);
        }
        __syncthreads();
    }
}

DI void p0_transpose_item(const float* W, int N, int k0, int src_n0, bf16_t* WT, int Kdst, int dst_r0, LAS float* scr, int lane) {
#pragma unroll 8
    for (int i = 0; i < 32; ++i) { const int kk = 2 * i + (lane >> 5); scr[kk * 33 + (lane & 31)] = W[(size_t)(k0 + kk) * N + src_n0 + (lane & 31)]; }
    asm volatile("s_waitcnt lgkmcnt(0)" ::: "memory");
    const int c = lane & 7;
#pragma unroll
    for (int j = 0; j < 4; ++j) { const int n = (lane >> 3) + 8 * j; const LAS float* s = scr + (8 * c) * 33 + n;
        u32x4 o; o.x = pk2(s[0 * 33], s[1 * 33]); o.y = pk2(s[2 * 33], s[3 * 33]); o.z = pk2(s[4 * 33], s[5 * 33]); o.w = pk2(s[6 * 33], s[7 * 33]);
        *(u32x4*)(WT + (size_t)(dst_r0 + n) * Kdst + k0 + 8 * c) = o; }
    asm volatile("s_waitcnt lgkmcnt(0)" ::: "memory");
}
DI const float* xrow_ptr(const Params& p, int row) { return row < MP ? p.in[0] + (size_t)row * DM : p.in[1] + (size_t)(row - MP) * DM; }

DI void phase_prep(const Params& p, LAS unsigned char* lds) {
    const int tid = threadIdx.x, lane = tid & 63, wave = tid >> 6;
    const int gw = blockIdx.x * 8 + wave, NGW = gridDim.x * 8;
    LAS float* scr = (LAS float*)(lds + wave * 16384);
    unsigned char* ws = p.ws;
    constexpr int I_IN = 16 * 256, I_SQ = 16 * 32, I_FI = 16 * 176, I_FO = 44 * 32, I_L = 8 * 8;
    constexpr int NITEMS = I_IN + 3 * I_SQ + I_FI + I_FO + 2 * I_L;
    for (int it = gw; it < NITEMS; it += NGW) {
        int r = it;
        if (r < I_IN) { const int kb = r / 256, nb = r % 256; p0_transpose_item(p.in[9], 8192, 64 * kb, 32 * nb, (bf16_t*)(ws + WS_WIN), 1024, 32 * nb, scr, lane); continue; } r -= I_IN;
        if (r < 3 * I_SQ) { const int w = r / I_SQ, q = r % I_SQ, kb = q / 32, nb = q % 32;
            p0_transpose_item(p.in[w == 0 ? 19 : (w == 1 ? 20 : 21)], 1024, 64 * kb, 32 * nb, (bf16_t*)(ws + (w == 0 ? WS_WPA : (w == 1 ? WS_WPB : WS_WO))), 1024, 32 * nb, scr, lane); continue; } r -= 3 * I_SQ;
        if (r < I_FI) { const int kb = r / 176, nb = r % 176, d0 = 32 * nb, pn = d0 >> 8, h = (d0 >> 7) & 1, j = d0 & 127;
            p0_transpose_item(p.in[22], NFI, 64 * kb, h * DFF + pn * 128 + j, (bf16_t*)(ws + WS_WFI), 1024, d0, scr, lane); continue; } r -= I_FI;
        if (r < I_FO) { const int kb = r / 32, nb = r % 32; p0_transpose_item(p.in[23], 1024, 64 * kb, 32 * nb, (bf16_t*)(ws + WS_WFO), DFF, 32 * nb, scr, lane); continue; } r -= I_FO;
        { const int w = r / I_L, q = r % I_L, blk = q / 8, kb = (q % 8) / 4, nb = q % 4;
          p0_transpose_item(p.in[w == 0 ? 14 : 16] + (size_t)blk * 16384, 128, 64 * kb, 32 * nb, (bf16_t*)(ws + (w == 0 ? WS_WLA : WS_WLX)) + (size_t)blk * 16384, 128, 32 * nb, scr, lane); }
    }
    bf16_t* XN = (bf16_t*)p.out;
    const float* g = p.in[5];
    for (int m = gw; m < MT; m += NGW) {
        u32x2* o = (u32x2*)(XN + (size_t)m * DM) + lane;
        if (m >= MR) {
#pragma unroll
            for (int j = 0; j < 4; ++j) o[64 * j] = (u32x2){0u, 0u};
            continue; }
        const f32x4* xr = (const f32x4*)xrow_ptr(p, m) + lane;
        f32x4 v[4]; float s = 0.f;
#pragma unroll
        for (int j = 0; j < 4; ++j) { v[j] = xr[64 * j]; s += (v[j].x * v[j].x + v[j].y * v[j].y) + (v[j].z * v[j].z + v[j].w * v[j].w); }
        const float rstd = rsqrtf(wave_sum(s) * (1.f / DM) + EPS);
#pragma unroll
        for (int j = 0; j < 4; ++j) { const f32x4 gg = ((const f32x4*)g)[lane + 64 * j];
            o[64 * j] = (u32x2){pk2(v[j].x * rstd * gg.x, v[j].y * rstd * gg.y), pk2(v[j].z * rstd * gg.z, v[j].w * rstd * gg.w)}; }
    }
    for (int i = blockIdx.x * NTHREADS + tid; i < MS * 2 * 1024; i += gridDim.x * NTHREADS) {
        const int b = i / 2048, r = (i / 1024) & 1, c = i & 1023;
        p.out[O_CVS + ((size_t)b * 3 + r) * 1024 + c] = p.in[4][((size_t)b * 3 + r + 1) * 1024 + c];
    }
}

DI void phase_r1(const Params& p, const float* MO, bf16_t* HN) {
    const int tid = threadIdx.x, lane = tid & 63, wave = tid >> 6;
    const int gw = blockIdx.x * 8 + wave, NGW = gridDim.x * 8;
    const float* g1 = p.in[6]; const float* g2 = p.in[7];
    for (int m = gw; m < MR; m += NGW) {
        const f32x4* xr = (const f32x4*)xrow_ptr(p, m) + lane;
        const f32x4* mr = (const f32x4*)(MO + (size_t)m * DM) + lane;
        f32x4 x[4], o[4]; float s = 0.f;
#pragma unroll
        for (int j = 0; j < 4; ++j) { x[j] = xr[64 * j]; o[j] = mr[64 * j]; s += (o[j].x * o[j].x + o[j].y * o[j].y) + (o[j].z * o[j].z + o[j].w * o[j].w); }
        const float r1 = rsqrtf(wave_sum(s) * (1.f / DM) + EPS);
        float s2 = 0.f;
#pragma unroll
        for (int j = 0; j < 4; ++j) { const f32x4 gg = ((const f32x4*)g1)[lane + 64 * j]; x[j] = x[j] + o[j] * r1 * gg; s2 += (x[j].x * x[j].x + x[j].y * x[j].y) + (x[j].z * x[j].z + x[j].w * x[j].w); }
        const float r2 = rsqrtf(wave_sum(s2) * (1.f / DM) + EPS);
        f32x4* yo = (f32x4*)(p.out + O_Y + (size_t)m * DM) + lane;
        u32x2* ho = (u32x2*)(HN + (size_t)m * DM) + lane;
#pragma unroll
        for (int j = 0; j < 4; ++j) { yo[64 * j] = x[j]; const f32x4 gg = ((const f32x4*)g2)[lane + 64 * j];
            ho[64 * j] = (u32x2){pk2(x[j].x * r2 * gg.x, x[j].y * r2 * gg.y), pk2(x[j].z * r2 * gg.z, x[j].w * r2 * gg.w)}; }
    }
}
DI void phase_r2(const Params& p, const float* FO) {
    const int tid = threadIdx.x, lane = tid & 63, wave = tid >> 6;
    const int gw = blockIdx.x * 8 + wave, NGW = gridDim.x * 8;
    const float* g = p.in[8];
    for (int m = gw; m < MR; m += NGW) {
        f32x4* yr = (f32x4*)(p.out + O_Y + (size_t)m * DM) + lane;
        const f32x4* fr = (const f32x4*)(FO + (size_t)m * DM) + lane;
        f32x4 x[4], o[4]; float s = 0.f;
#pragma unroll
        for (int j = 0; j < 4; ++j) { x[j] = yr[64 * j]; o[j] = fr[64 * j]; s += (o[j].x * o[j].x + o[j].y * o[j].y) + (o[j].z * o[j].z + o[j].w * o[j].w); }
        const float r1 = rsqrtf(wave_sum(s) * (1.f / DM) + EPS);
#pragma unroll
        for (int j = 0; j < 4; ++j) { const f32x4 gg = ((const f32x4*)g)[lane + 64 * j]; yr[64 * j] = x[j] + o[j] * r1 * gg; }
    }
}

constexpr int HG_GRAW = 0, HG_BC = 16384, HG_TOT = 49152, HG_QT = 51200, HG_KT = 68608, HG_KTT = 86016, HG_VT = 104448, HG_PB = 122880, HG_OB = 0, HG_END = 132096;
constexpr int QS = 136, TS = 72, OS = 132;

DI void hgrn_prompt_item(const Params& p, LAS unsigned char* lds, int b, int h) {
    const int tid = threadIdx.x, lane = tid & 63, w = tid >> 6, fr = lane & 15, fg = lane >> 4;
    const bf16_t* SQ = (const bf16_t*)(p.ws + WS_SEG);
    const bf16_t* SG = SQ + (size_t)MT * 1024; const bf16_t* SV = SG + (size_t)MT * 1024; const bf16_t* SO = SV + (size_t)MT * 1024;
    bf16_t* AIN = (bf16_t*)(p.ws + WS_AIN);
    LAS bf16_t* Graw = (LAS bf16_t*)(lds + HG_GRAW); LAS float* BC = (LAS float*)(lds + HG_BC); LAS float* TOT = (LAS float*)(lds + HG_TOT);
    LAS bf16_t* QT = (LAS bf16_t*)(lds + HG_QT); LAS bf16_t* KT = (LAS bf16_t*)(lds + HG_KT); LAS bf16_t* KTT = (LAS bf16_t*)(lds + HG_KTT);
    LAS bf16_t* VT = (LAS bf16_t*)(lds + HG_VT); LAS bf16_t* PB = (LAS bf16_t*)(lds + HG_PB); LAS float* OB = (LAS float*)(lds + HG_OB);
    const int as = tid >> 3, akg = tid & 7;
    const int bk = tid & 127, bj = tid >> 7;
    f32x4 Sacc[8];
#pragma unroll
    for (int i = 0; i < 8; ++i) Sacc[i] = (f32x4){0.f, 0.f, 0.f, 0.f};
    const size_t rowbase = (size_t)b * TSEQ;
    const int colh = h * 128;
    u32x4 rq[2], rg[2], rv[2];
    { const size_t off = (rowbase + as) * 1024 + colh + 16 * akg;
      rq[0] = *(const u32x4*)(SQ + off); rq[1] = *(const u32x4*)(SQ + off + 8); rg[0] = *(const u32x4*)(SG + off); rg[1] = *(const u32x4*)(SG + off + 8);
      rv[0] = *(const u32x4*)(SV + off); rv[1] = *(const u32x4*)(SV + off + 8); }
    const float on_lo = 0.f; (void)on_lo;
    for (int c = 0; c < TSEQ / 64; ++c) {
        *(LAS u32x4*)(Graw + as * 128 + 16 * akg) = rg[0]; *(LAS u32x4*)(Graw + as * 128 + 16 * akg + 8) = rg[1];
        { const unsigned vw[8] = {rv[0].x, rv[0].y, rv[0].z, rv[0].w, rv[1].x, rv[1].y, rv[1].z, rv[1].w};
#pragma unroll
          for (int i = 0; i < 8; ++i) { VT[(16 * akg + 2 * i) * TS + as] = (bf16_t)(vw[i] & 0xffffu); VT[(16 * akg + 2 * i + 1) * TS + as] = (bf16_t)(vw[i] >> 16); } }
        float qf[16], gf[16];
        unpack8(rq[0], *(float(*)[8])&qf[0]); unpack8(rq[1], *(float(*)[8])&qf[8]);
        unpack8(rg[0], *(float(*)[8])&gf[0]); unpack8(rg[1], *(float(*)[8])&gf[8]);
        if (c + 1 < TSEQ / 64) { const size_t off = (rowbase + (size_t)(c + 1) * 64 + as) * 1024 + colh + 16 * akg;
            rq[0] = *(const u32x4*)(SQ + off); rq[1] = *(const u32x4*)(SQ + off + 8); rg[0] = *(const u32x4*)(SG + off); rg[1] = *(const u32x4*)(SG + off + 8);
            rv[0] = *(const u32x4*)(SV + off); rv[1] = *(const u32x4*)(SV + off + 8); }
        __syncthreads();
        float gl[16], lc[16];
        { float run = 0.f;
#pragma unroll
          for (int i = 0; i < 16; ++i) { gl[i] = bf2f(Graw[(16 * bj + i) * 128 + bk]); run += gl[i]; lc[i] = run; }
          TOT[bj * 128 + bk] = run; }
        __syncthreads();
        float base = 0.f, total = 0.f;
#pragma unroll
        for (int j = 0; j < 4; ++j) { const float t = TOT[j * 128 + bk]; base += (j < bj) ? t : 0.f; total += t; }
        {
            unsigned kw[8];
#pragma unroll
            for (int i = 0; i < 16; i += 2) {
                const float b0 = base + lc[i], b1 = base + lc[i + 1];
                BC[(16 * bj + i) * 128 + bk] = b0; BC[(16 * bj + i + 1) * 128 + bk] = b1;
                const float k0 = (1.0f - fexp(gl[i])) * fexp(total - b0), k1 = (1.0f - fexp(gl[i + 1])) * fexp(total - b1);
                kw[i >> 1] = pk2(k0, k1);
            }
            *(LAS u32x4*)(KTT + bk * TS + 16 * bj) = (u32x4){kw[0], kw[1], kw[2], kw[3]};
            *(LAS u32x4*)(KTT + bk * TS + 16 * bj + 8) = (u32x4){kw[4], kw[5], kw[6], kw[7]};
        }
        __syncthreads();
        {
            float bc[16];
#pragma unroll
            for (int i = 0; i < 4; ++i) { const f32x4 t = *(const LAS f32x4*)(BC + as * 128 + 16 * akg + 4 * i); bc[4 * i] = t.x; bc[4 * i + 1] = t.y; bc[4 * i + 2] = t.z; bc[4 * i + 3] = t.w; }
            unsigned qw[8], kw[8];
#pragma unroll
            for (int i = 0; i < 16; i += 2) {
                const float e0 = fexp(bc[i]), e1 = fexp(bc[i + 1]);
                const float n0 = fexp(fminf(-bc[i], 80.f)), n1 = fexp(fminf(-bc[i + 1], 80.f));
                qw[i >> 1] = pk2(qf[i] * e0, qf[i + 1] * e1);
                kw[i >> 1] = pk2((1.0f - fexp(gf[i])) * n0, (1.0f - fexp(gf[i + 1])) * n1);
            }
            *(LAS u32x4*)(QT + as * QS + 16 * akg) = (u32x4){qw[0], qw[1], qw[2], qw[3]}; *(LAS u32x4*)(QT + as * QS + 16 * akg + 8) = (u32x4){qw[4], qw[5], qw[6], qw[7]};
            *(LAS u32x4*)(KT + as * QS + 16 * akg) = (u32x4){kw[0], kw[1], kw[2], kw[3]}; *(LAS u32x4*)(KT + as * QS + 16 * akg + 8) = (u32x4){kw[4], kw[5], kw[6], kw[7]};
        }
        __syncthreads();
#pragma unroll
        for (int q2 = 0; q2 < 2; ++q2) {
            const int id = 2 * w + q2, ti = id >> 2, si = id & 3;
            f32x4 pacc = (f32x4){0.f, 0.f, 0.f, 0.f};
            if (si <= ti) {
#pragma unroll
                for (int ks = 0; ks < 4; ++ks) {
                    const bf16x8 a = *(const LAS bf16x8*)(KT + (16 * si + fr) * QS + 32 * ks + 8 * fg);
                    const bf16x8 bq = *(const LAS bf16x8*)(QT + (16 * ti + fr) * QS + 32 * ks + 8 * fg);
                    pacc = __builtin_amdgcn_mfma_f32_16x16x32_bf16(a, bq, pacc, 0, 0, 0);
                }
            }
            const int t = 16 * ti + fr, s0 = 16 * si + 4 * fg;
            float pv[4];
#pragma unroll
            for (int j = 0; j < 4; ++j) pv[j] = (s0 + j <= t) ? pacc[j] : 0.f;
            *(LAS u32x2*)(PB + t * TS + s0) = (u32x2){pk2(pv[0], pv[1]), pk2(pv[2], pv[3])};
        }
        f32x4 oacc[4];
#pragma unroll
        for (int ti = 0; ti < 4; ++ti) oacc[ti] = (f32x4){0.f, 0.f, 0.f, 0.f};
#pragma unroll
        for (int pp = 0; pp < 4; ++pp) {
            const u32x4 sb = pack8(Sacc[2 * pp], Sacc[2 * pp + 1]);
            const bf16x8 bfrag = __builtin_bit_cast(bf16x8, sb);
#pragma unroll
            for (int ti = 0; ti < 4; ++ti) {
                const u32x2 lo = *(const LAS u32x2*)(QT + (16 * ti + fr) * QS + 32 * pp + 4 * fg);
                const u32x2 hi = *(const LAS u32x2*)(QT + (16 * ti + fr) * QS + 32 * pp + 16 + 4 * fg);
                const bf16x8 a = __builtin_bit_cast(bf16x8, (u32x4){lo.x, lo.y, hi.x, hi.y});
                oacc[ti] = __builtin_amdgcn_mfma_f32_16x16x32_bf16(a, bfrag, oacc[ti], 0, 0, 0);
            }
        }
        {
            const float dk = 0.f; (void)dk;
            bf16x8 vb[2];
#pragma unroll
            for (int ks = 0; ks < 2; ++ks) vb[ks] = *(const LAS bf16x8*)(VT + (16 * w + fr) * TS + 32 * ks + 8 * fg);
#pragma unroll
            for (int kt = 0; kt < 8; ++kt) {
                float dsc[4];
#pragma unroll
                for (int j = 0; j < 4; ++j) { const int k = 16 * kt + 4 * fg + j; dsc[j] = fexp(TOT[k] + TOT[128 + k] + TOT[256 + k] + TOT[384 + k]); }
                f32x4 sa = Sacc[kt];
#pragma unroll
                for (int j = 0; j < 4; ++j) sa[j] *= dsc[j];
#pragma unroll
                for (int ks = 0; ks < 2; ++ks) {
                    const bf16x8 a = *(const LAS bf16x8*)(KTT + (16 * kt + fr) * TS + 32 * ks + 8 * fg);
                    sa = __builtin_amdgcn_mfma_f32_16x16x32_bf16(a, vb[ks], sa, 0, 0, 0);
                }
                Sacc[kt] = sa;
            }
            __syncthreads();
#pragma unroll
            for (int ti = 0; ti < 4; ++ti) {
#pragma unroll
                for (int ks = 0; ks < 2; ++ks) {
                    if (ks * 32 <= ti * 16 + 15) {
                        const bf16x8 a = *(const LAS bf16x8*)(PB + (16 * ti + fr) * TS + 32 * ks + 8 * fg);
                        oacc[ti] = __builtin_amdgcn_mfma_f32_16x16x32_bf16(a, vb[ks], oacc[ti], 0, 0, 0);
                    }
                }
            }
        }
#pragma unroll
        for (int ti = 0; ti < 4; ++ti)
#pragma unroll
            for (int j = 0; j < 4; ++j) OB[(16 * ti + 4 * fg + j) * OS + 16 * w + fr] = oacc[ti][j];
        __syncthreads();
        {
            float o[16]; float ss = 0.f;
#pragma unroll
            for (int i = 0; i < 4; ++i) { const f32x4 t = *(const LAS f32x4*)(OB + as * OS + 16 * akg + 4 * i); o[4 * i] = t.x; o[4 * i + 1] = t.y; o[4 * i + 2] = t.z; o[4 * i + 3] = t.w; ss += (t.x * t.x + t.y * t.y) + (t.z * t.z + t.w * t.w); }
            ss += __shfl_xor(ss, 1); ss += __shfl_xor(ss, 2); ss += __shfl_xor(ss, 4);
            const float rstd = rsqrtf(ss * (1.f / 128.f) + EPS);
            const size_t off = (rowbase + (size_t)c * 64 + as) * 1024 + colh + 16 * akg;
            float gt[16]; unpack8(*(const u32x4*)(SO + off), *(float(*)[8])&gt[0]); unpack8(*(const u32x4*)(SO + off + 8), *(float(*)[8])&gt[8]);
            const float* onw = p.in[11] + 16 * akg;
            unsigned ow[8];
#pragma unroll
            for (int i = 0; i < 16; i += 2) ow[i >> 1] = pk2(o[i] * rstd * onw[i] * gt[i], o[i + 1] * rstd * onw[i + 1] * gt[i + 1]);
            *(u32x4*)(AIN + off) = (u32x4){ow[0], ow[1], ow[2], ow[3]}; *(u32x4*)(AIN + off + 8) = (u32x4){ow[4], ow[5], ow[6], ow[7]};
        }
        __syncthreads();
    }
    float* so = p.out + O_HGP + ((size_t)b * 8 + h) * 16384;
#pragma unroll
    for (int kt = 0; kt < 8; ++kt)
#pragma unroll
        for (int j = 0; j < 4; ++j) so[(16 * kt + 4 * fg + j) * 128 + 16 * w + fr] = Sacc[kt][j];
}

DI void hgrn_sample_item(const Params& p, LAS unsigned char* lds, int bs, int h) {
    const int tid = threadIdx.x;
    const bf16_t* SQ = (const bf16_t*)(p.ws + WS_SEG);
    const bf16_t* SG = SQ + (size_t)MT * 1024; const bf16_t* SV = SG + (size_t)MT * 1024; const bf16_t* SO = SV + (size_t)MT * 1024;
    bf16_t* AIN = (bf16_t*)(p.ws + WS_AIN);
    LAS float* RED = (LAS float*)lds;
    LAS float* RSS = (LAS float*)(lds + 8192);
    const size_t roff = (size_t)(MP + bs) * 1024 + h * 128;
    const int v4 = (tid & 31) * 4, kq = tid >> 5;
    const float* S0 = p.in[2] + ((size_t)bs * 8 + h) * 16384;
    float* S1 = p.out + O_HGS + ((size_t)bs * 8 + h) * 16384;
    const u32x2 vw = *(const u32x2*)(SV + roff + v4);
    const f32x4 vv = (f32x4){bflo(vw.x), bfhi(vw.x), bflo(vw.y), bfhi(vw.y)};
    f32x4 op = (f32x4){0.f, 0.f, 0.f, 0.f};
#pragma unroll
    for (int i = 0; i < 8; ++i) {
        const int k = 8 * kq + i;
        const float f = fexp(bf2f(SG[roff + k])), kk = 1.0f - f, q = bf2f(SQ[roff + k]);
        const f32x4 s0 = *(const f32x4*)(S0 + (size_t)k * 128 + v4);
        const f32x4 sn = s0 * f + vv * kk;
        *(f32x4*)(S1 + (size_t)k * 128 + v4) = sn;
        op += sn * q;
    }
    *(LAS f32x4*)(RED + kq * 128 + v4) = op;
    __syncthreads();
    float o = 0.f;
    if (tid < 128) {
#pragma unroll
        for (int j = 0; j < 16; ++j) o += RED[j * 128 + tid];
        const float ss = wave_sum(o * o);
        if ((tid & 63) == 0) RSS[tid >> 6] = ss;
    }
    __syncthreads();
    if (tid < 128) {
        const float rstd = rsqrtf((RSS[0] + RSS[1]) * (1.f / 128.f) + EPS);
        const float r = o * rstd * p.in[11][tid] * bf2f(SO[roff + tid]);
        AIN[roff + tid] = (bf16_t)f2bf(r);
    }
    __syncthreads();
}

DI void phase_hgrn(const Params& p, LAS unsigned char* lds) {
    const int NI = 64 + MS * 8;
    for (int it = blockIdx.x; it < NI; it += gridDim.x) {
        if (it < 64) hgrn_prompt_item(p, lds, it >> 3, it & 7);
        else { const int r = it - 64; hgrn_sample_item(p, lds, r >> 3, r & 7); }
    }
}

constexpr int LR_XC = 0, LR_RA = 69632, LR_IX = 103424, LR_COMP = 137216, LR_END = 141312;
constexpr int XS = 136, RS = 33;
DI float neg_expm1(float x) {
    if (x > -0.1f) { return -x * (1.0f + x * (0.5f + x * (0.16666667f + x * 0.041666668f))); }
    return 1.0f - fexp(x);
}
DI void lru_item(const Params& p, LAS unsigned char* lds, bool sample, int b, int n, int dq) {
    const int tid0 = threadIdx.x, fr0 = tid0 & 15;
    const bf16_t* SLX = (const bf16_t*)(p.ws + WS_SEG); const bf16_t* SLY = SLX + (size_t)MT * 1024;
    bf16_t* BIN = (bf16_t*)(p.ws + WS_BIN);
    LAS bf16_t* XC = (LAS bf16_t*)(lds + LR_XC); LAS float* RA = (LAS float*)(lds + LR_RA); LAS float* IX = (LAS float*)(lds + LR_IX); LAS f32x2* COMP = (LAS f32x2*)(lds + LR_COMP);
    const int ch0 = n * 128;
    const float bias_a0 = p.in[15][ch0 + 32 * dq + fr0], bias_a1 = p.in[15][ch0 + 32 * dq + 16 + fr0];
    const float bias_x0 = p.in[17][ch0 + 32 * dq + fr0], bias_x1 = p.in[17][ch0 + 32 * dq + 16 + fr0];
    const float lam = p.in[18][ch0 + 32 * dq + (tid0 & 31)];
    const float sp8 = 8.0f * (lam > 15.f ? fexp(-lam) : log1pf(fexp(-lam)));
    float hcar = 0.f;
    const int ntiles = sample ? 1 : (TSEQ / 256);
    for (int tile = 0; tile < ntiles; ++tile) {
        const int t0 = tile * 256;
        int tid = threadIdx.x; asm volatile("" : "+v"(tid));
        const int lane = tid & 63, w = tid >> 6, fr = lane & 15, fg = lane >> 4;
        const int c8 = tid & 15, tr = tid >> 4;
        const int sd = tid & 31, sub = tid >> 5, sch = ch0 + 32 * dq + sd;
        {
        float cw[4][8], cbv[8];
#pragma unroll
        for (int j = 0; j < 4; ++j) { const f32x4 w0 = *(const f32x4*)(p.in[12] + j * 1024 + ch0 + 8 * c8), w1 = *(const f32x4*)(p.in[12] + j * 1024 + ch0 + 8 * c8 + 4);
            cw[j][0] = w0.x; cw[j][1] = w0.y; cw[j][2] = w0.z; cw[j][3] = w0.w; cw[j][4] = w1.x; cw[j][5] = w1.y; cw[j][6] = w1.z; cw[j][7] = w1.w; }
        { const f32x4 w0 = *(const f32x4*)(p.in[13] + ch0 + 8 * c8), w1 = *(const f32x4*)(p.in[13] + ch0 + 8 * c8 + 4);
            cbv[0] = w0.x; cbv[1] = w0.y; cbv[2] = w0.z; cbv[3] = w0.w; cbv[4] = w1.x; cbv[5] = w1.y; cbv[6] = w1.z; cbv[7] = w1.w; }
        if (!sample) {
#pragma unroll 1
            for (int hh2 = 0; hh2 < 2; ++hh2) {
                float xin[7][8];
#pragma unroll
                for (int r = 0; r < 7; ++r) {
                    const int t = t0 + 8 * tr + 4 * hh2 - 3 + r;
                    if (t >= 0) unpack8(*(const u32x4*)(SLX + ((size_t)b * TSEQ + t) * 1024 + ch0 + 8 * c8), xin[r]);
                    else {
#pragma unroll
                        for (int i = 0; i < 8; ++i) xin[r][i] = 0.f; }
                }
#pragma unroll
                for (int r = 0; r < 4; ++r) {
                    float y[8];
#pragma unroll
                    for (int i = 0; i < 8; ++i) y[i] = cbv[i] + xin[r][i] * cw[0][i] + xin[r + 1][i] * cw[1][i] + xin[r + 2][i] * cw[2][i] + xin[r + 3][i] * cw[3][i];
                    *(LAS u32x4*)(XC + (8 * tr + 4 * hh2 + r) * XS + 8 * c8) = (u32x4){pk2(y[0], y[1]), pk2(y[2], y[3]), pk2(y[4], y[5]), pk2(y[6], y[7])};
                }
            }
        } else {
#pragma unroll
            for (int r = 0; r < 4; ++r) {
                const int bs = 4 * tr + r;
                float y[8], lx[8];
                unpack8(*(const u32x4*)(SLX + (size_t)(MP + bs) * 1024 + ch0 + 8 * c8), lx);
                const float* cs = p.in[4] + (size_t)bs * 3 * 1024 + ch0 + 8 * c8;
#pragma unroll
                for (int i = 0; i < 8; ++i) y[i] = cbv[i] + cs[i] * cw[0][i] + cs[1024 + i] * cw[1][i] + cs[2048 + i] * cw[2][i] + lx[i] * cw[3][i];
                *(LAS u32x4*)(XC + bs * XS + 8 * c8) = (u32x4){pk2(y[0], y[1]), pk2(y[2], y[3]), pk2(y[4], y[5]), pk2(y[6], y[7])};
            }
        }
        }
        __syncthreads();
        {
        bf16x8 wb[2][2][4];
        {
            const bf16_t* WA = (const bf16_t*)(p.ws + WS_WLA) + (size_t)n * 16384; const bf16_t* WX = (const bf16_t*)(p.ws + WS_WLX) + (size_t)n * 16384;
#pragma unroll
            for (int nt = 0; nt < 2; ++nt)
#pragma unroll
                for (int ks = 0; ks < 4; ++ks) {
                    const int off = (32 * dq + 16 * nt + fr) * 128 + 32 * ks + 8 * fg;
                    wb[0][nt][ks] = *(const bf16x8*)(WA + off); wb[1][nt][ks] = *(const bf16x8*)(WX + off);
                }
        }
#pragma unroll
        for (int tt2 = 0; tt2 < 2; ++tt2) {
            const int tt = 2 * w + tt2;
            if (sample && tt >= 8) break;
            f32x4 acc[2][2];
#pragma unroll
            for (int m = 0; m < 2; ++m)
#pragma unroll
                for (int nt = 0; nt < 2; ++nt) acc[m][nt] = (f32x4){0.f, 0.f, 0.f, 0.f};
#pragma unroll
            for (int ks = 0; ks < 4; ++ks) {
                const bf16x8 a = *(const LAS bf16x8*)(XC + (16 * tt + fr) * XS + 32 * ks + 8 * fg);
#pragma unroll
                for (int m = 0; m < 2; ++m)
#pragma unroll
                    for (int nt = 0; nt < 2; ++nt) acc[m][nt] = __builtin_amdgcn_mfma_f32_16x16x32_bf16(a, wb[m][nt][ks], acc[m][nt], 0, 0, 0);
            }
#pragma unroll
            for (int nt = 0; nt < 2; ++nt)
#pragma unroll
                for (int j = 0; j < 4; ++j) {
                    RA[(16 * tt + 4 * fg + j) * RS + 16 * nt + fr] = acc[0][nt][j] + (nt ? bias_a1 : bias_a0);
                    IX[(16 * tt + 4 * fg + j) * RS + 16 * nt + fr] = acc[1][nt][j] + (nt ? bias_x1 : bias_x0);
                }
        }
        }
        __syncthreads();
        if (!sample) {
            float av[16], bv[16]; float Ap = 1.f, Hl = 0.f;
#pragma unroll
            for (int i = 0; i < 16; ++i) {
                const int tl = 16 * sub + i;
                const float ra = RA[tl * RS + sd], ix = IX[tl * RS + sd], xc = bf2f(XC[tl * XS + 32 * dq + sd]);
                const float la = -sp8 * sigm(ra);
                const float a = fexp(la);
                float mult = sqrtf(neg_expm1(2.0f * la));
                if (t0 + tl == 0) mult = 1.0f;
                const float bb = mult * sigm(ix) * xc;
                av[i] = a; bv[i] = bb; Hl = a * Hl + bb; Ap *= a;
            }
            COMP[sub * 32 + sd] = (f32x2){Ap, Hl};
            __syncthreads();
            float hin = hcar, hall = hcar;
#pragma unroll
            for (int s2 = 0; s2 < 16; ++s2) { const f32x2 cpp = COMP[s2 * 32 + sd]; hall = cpp.x * hall + cpp.y; if (s2 < sub) hin = hall; }
            hcar = hall;
            float hh = hin;
#pragma unroll
            for (int i = 0; i < 16; ++i) {
                hh = av[i] * hh + bv[i];
                const size_t off = ((size_t)b * TSEQ + t0 + 16 * sub + i) * 1024 + sch;
                BIN[off] = (bf16_t)f2bf(bf2f(SLY[off]) * hh);
            }
            if (tile == ntiles - 1 && sub == 15) p.out[O_LRUP + (size_t)b * 1024 + sch] = hh;
        } else {
#pragma unroll
            for (int i = 0; i < 8; ++i) {
                const int bs = 8 * sub + i;
                const float ra = RA[bs * RS + sd], ix = IX[bs * RS + sd], xc = bf2f(XC[bs * XS + 32 * dq + sd]);
                const float la = -sp8 * sigm(ra);
                const float a = fexp(la), mult = sqrtf(neg_expm1(2.0f * la));
                const float hh = a * p.in[3][(size_t)bs * 1024 + sch] + mult * sigm(ix) * xc;
                const size_t off = (size_t)(MP + bs) * 1024 + sch;
                BIN[off] = (bf16_t)f2bf(bf2f(SLY[off]) * hh);
                p.out[O_LRUS + (size_t)bs * 1024 + sch] = hh;
            }
        }
        __syncthreads();
    }
}
DI void phase_lru(const Params& p, LAS unsigned char* lds) {
    const int NI = 256 + 32;
    for (int it = blockIdx.x; it < NI; it += gridDim.x) {
        if (it < 256) lru_item(p, lds, false, it >> 5, (it >> 2) & 7, it & 3);
        else { const int r = it - 256; lru_item(p, lds, true, 0, r >> 2, r & 3); }
    }
}

constexpr int LDS_BYTES = 144 * 1024;
static_assert(HG_END <= LDS_BYTES - 16 && LR_END <= LDS_BYTES - 16 && pg8::STAGE_BYTES <= LDS_BYTES - 16 && 2 * RED_BYTES <= LDS_BYTES - 16, "lds");

__global__ void __launch_bounds__(NTHREADS) fwd_kernel(Params p) {
    extern __shared__ __attribute__((aligned(16))) unsigned char lds_raw[];
    LAS unsigned char* lds = (LAS unsigned char*)lds_raw;
    cg::grid_group grid = cg::this_grid();
    if (p.ph_hi < 0) grid.sync();
    volatile LAS unsigned* bst = (volatile LAS unsigned*)(lds + LDS_BYTES - 16);
    if (threadIdx.x < 4) bst[threadIdx.x] = 0u;
    __syncthreads();
    const XcdBarrier xbar = xcd_barrier_post((unsigned*)(p.ws + WS_BAR), bst);
    const int lo = p.ph_lo, hi = p.ph_hi;
    unsigned char* ws = p.ws;
    bf16_t* SEG = (bf16_t*)(ws + WS_SEG);
    bf16_t* XN = (bf16_t*)p.out;
    const int G = gridDim.x, c = blockIdx.x;
    constexpr int NM = MP / 256;
#ifndef PHMASK
#define PHMASK 0x7ff
#endif
#define IN(k) (((PHMASK >> (k)) & 1) && lo <= (k) && (k) < hi)
#define SYNC(k) do { if (IN(k) && IN((k) + 1)) xcd_barrier(xbar); } while (0)
#ifndef DUPMASK
#define DUPMASK 0
#endif
#define DUP(k) (((DUPMASK >> (k)) & 1) ? 2 : 1)
#define RUN(k, ...) do { if (IN(k)) for (int rep = 0; rep < DUP(k); ++rep) { if (rep) xcd_barrier(xbar); __VA_ARGS__ } } while (0)
    RUN(0, phase_prep(p, lds););
    SYNC(0);
    RUN(1, { pg8::Order S; S.init(NM, 16, G, c, 1024, XN, (const bf16_t*)(ws + WS_WIN));
        pg8::EpiProjH E{SEG, p.in[10]}; pg8::gemm_phase(lds, S, E); skinny_proj(p, lds, 0); });
    SYNC(1);
    RUN(2, phase_hgrn(p, lds););
    SYNC(2);
    RUN(3, { pg8::Order S; S.init(NM, 16, G, c, 1024, XN, (const bf16_t*)(ws + WS_WIN) + (size_t)4096 * 1024);
        pg8::EpiProjL E{SEG, p.out}; pg8::gemm_phase(lds, S, E); skinny_proj(p, lds, 1); });
    SYNC(3);
    RUN(4, phase_lru(p, lds););
    SYNC(4);
    RUN(5, { pg8::Order S; S.init(NM, 4, G, c, 1024, (const bf16_t*)(ws + WS_AIN), (const bf16_t*)(ws + WS_WPA), 2, (const bf16_t*)(ws + WS_BIN), (const bf16_t*)(ws + WS_WPB));
        pg8::EpiMerge E{SEG + (size_t)2 * MT * 1024, SEG + (size_t)3 * MT * 1024, SEG}; pg8::gemm_phase(lds, S, E); skinny_merge(p, lds); });
    SYNC(5);
    RUN(6, { pg8::Order S; S.init(NM, 4, G, c, 1024, SEG, (const bf16_t*)(ws + WS_WO));
        pg8::EpiF32 E{(float*)(SEG + (size_t)2 * MT * 1024)}; pg8::gemm_phase(lds, S, E); skinny_f32(lds, SEG, 1024, (const bf16_t*)(ws + WS_WO), (float*)(SEG + (size_t)2 * MT * 1024)); });
    SYNC(6);
    RUN(7, phase_r1(p, (const float*)(SEG + (size_t)2 * MT * 1024), SEG););
    SYNC(7);
    RUN(8, { pg8::Order S; S.init(NM, 22, G, c, 1024, SEG, (const bf16_t*)(ws + WS_WFI));
        pg8::EpiSwiGLU E{SEG + (size_t)MT * 1024}; pg8::gemm_phase(lds, S, E); skinny_swiglu(p, lds); });
    SYNC(8);
    RUN(9, { pg8::Order S; S.init(NM, 4, G, c, DFF, SEG + (size_t)MT * 1024, (const bf16_t*)(ws + WS_WFO));
        pg8::EpiF32 E{(float*)(ws + WS_AIN)}; pg8::gemm_phase(lds, S, E); skinny_f32(lds, SEG + (size_t)MT * 1024, DFF, (const bf16_t*)(ws + WS_WFO), (float*)(ws + WS_AIN)); });
    SYNC(9);
    RUN(10, phase_r2(p, (const float*)(ws + WS_AIN)););
#ifdef EXTRA_SYNCS
    for (int i = 0; i < EXTRA_SYNCS; ++i) xcd_barrier(xbar);
#endif
#undef RUN
#undef IN
#undef SYNC
}

constexpr int NPHASES = 11;
#ifndef MK_PER_PHASE
#define MK_PER_PHASE 0
#endif

extern "C" void kernel_launch(void* const* d_in, const int* in_sizes, int n_in, void* d_out, int out_size, void* d_ws, size_t ws_size, hipStream_t stream) {
    static int grid = 0;
    if (grid == 0) {
        int dev = 0, cus = 0, per_cu = 0;
        hipGetDevice(&dev);
        hipDeviceGetAttribute(&cus, hipDeviceAttributeMultiprocessorCount, dev);
        hipFuncSetAttribute((const void*)fwd_kernel, hipFuncAttributeMaxDynamicSharedMemorySize, LDS_BYTES);
        hipOccupancyMaxActiveBlocksPerMultiprocessor(&per_cu, (const void*)fwd_kernel, NTHREADS, LDS_BYTES);
        if (per_cu < 1) per_cu = 1;
        grid = cus * per_cu;
        if (ws_size < WS_END) fprintf(stderr, "kernel_launch: workspace too small: %zu < %zu\n", ws_size, (size_t)WS_END);
        fprintf(stderr, "kernel_launch: cus %d per_cu %d grid %d ws %zu\n", cus, per_cu, grid, ws_size);
    }
    Params p{};
    for (int i = 0; i < 24; ++i) p.in[i] = (const float*)d_in[i];
    p.out = (float*)d_out; p.ws = (unsigned char*)d_ws;
#if MK_PER_PHASE
    for (int ph = 0; ph < NPHASES; ++ph) {
        p.ph_lo = ph; p.ph_hi = ph + 1;
        hipLaunchKernelGGL(fwd_kernel, dim3(grid), dim3(NTHREADS), LDS_BYTES, stream, p);
    }
#else
    p.ph_lo = 0; p.ph_hi = NPHASES;
    (void)hipMemsetAsync((unsigned char*)d_ws + WS_BAR, 0, 16384, stream);
    void* args[] = {&p};
    hipError_t e = hipLaunchCooperativeKernel((const void*)fwd_kernel, dim3(grid), dim3(NTHREADS), args, LDS_BYTES, stream);
    if (e != hipSuccess) fprintf(stderr, "cooperative launch failed: %s (grid %d)\n", hipGetErrorString(e), grid);
#endif
}
```

```cpp
#include <hip/hip_runtime.h>
#include <hip/hip_cooperative_groups.h>
#include <cstdio>
namespace cg = cooperative_groups;

#define LAS __attribute__((address_space(3)))
typedef unsigned short bf16_t;
typedef short bf16x8 __attribute__((ext_vector_type(8)));
typedef short s16x4 __attribute__((ext_vector_type(4)));
typedef float f32x4 __attribute__((ext_vector_type(4)));
typedef float f32x2 __attribute__((ext_vector_type(2)));
typedef unsigned u32x4 __attribute__((ext_vector_type(4)));
typedef unsigned u32x2 __attribute__((ext_vector_type(2)));
#define DI __device__ __forceinline__

constexpr int MP = 16384, MS = 128, MR = MP + MS, MT = 16640;
constexpr int DM = 1024, TSEQ = 2048, NBATCH = 8, DFF = 2816, NFI = 5632;
constexpr float EPS = 1e-6f;
constexpr int NTHREADS = 512;

constexpr size_t O_Y = 0, O_HGP = 16908288, O_LRUP = 17956864, O_CVP = 17965056, O_HGS = 17989632, O_LRUS = 34766848, O_CVS = 34897920;
constexpr size_t SEGB = (size_t)MT * 1024 * 2;
constexpr size_t WS_WIN = 0;
constexpr size_t WS_WPA = WS_WIN + (size_t)8192 * 1024 * 2;
constexpr size_t WS_WPB = WS_WPA + (size_t)1024 * 1024 * 2;
constexpr size_t WS_WO  = WS_WPB + (size_t)1024 * 1024 * 2;
constexpr size_t WS_WFI = WS_WO + (size_t)1024 * 1024 * 2;
constexpr size_t WS_WFO = WS_WFI + (size_t)NFI * 1024 * 2;
constexpr size_t WS_WLA = WS_WFO + (size_t)1024 * DFF * 2;
constexpr size_t WS_WLX = WS_WLA + (size_t)8 * 128 * 128 * 2;
constexpr size_t WS_SEG = WS_WLX + (size_t)8 * 128 * 128 * 2;
constexpr size_t WS_AIN = WS_SEG + 4 * SEGB;
constexpr size_t WS_BIN = WS_AIN + SEGB;
constexpr size_t WS_BAR = WS_BIN + SEGB;
constexpr size_t WS_HC = WS_BAR + 16384;
constexpr size_t WS_HL = WS_HC + (size_t)64 * 3 * 16384 * 4;
constexpr size_t WS_END = WS_HL + (size_t)64 * 3 * 128 * 4;
static_assert(WS_END <= (size_t)256 * 1024 * 1024, "workspace");

struct Params { const float* in[24]; float* out; unsigned char* ws; int ph_lo, ph_hi; };

typedef __bf16 hbf16x2 __attribute__((ext_vector_type(2)));
DI unsigned pk2(float lo, float hi) { const f32x2 v = {lo, hi}; return __builtin_bit_cast(unsigned, __builtin_convertvector(v, hbf16x2)); }
DI unsigned f2bf(float f) { return pk2(f, 0.f) & 0xffffu; }
DI float fexp2(float x) { return __builtin_amdgcn_exp2f(x); }
DI float bf2f(unsigned short b) { return __builtin_bit_cast(float, ((unsigned)b) << 16); }
DI float bflo(unsigned w) { return __builtin_bit_cast(float, w << 16); }
DI float bfhi(unsigned w) { return __builtin_bit_cast(float, w & 0xffff0000u); }
DI float fexp(float x) { return __expf(x); }
DI float frcp(float x) { return __builtin_amdgcn_rcpf(x); }
DI float sigm(float x) { return frcp(1.0f + fexp(-x)); }
DI float silu(float x) { return x * sigm(x); }
DI float gelu_tanh(float x) { const float u = 1.5957691216f * (x + 0.044715f * x * x * x); return x * sigm(u); }
DI float wave_sum(float v) {
#pragma unroll
    for (int o = 1; o < 64; o <<= 1) v += __shfl_xor(v, o);
    return v;
}
DI u32x4 pack8(const f32x4& a, const f32x4& b) { u32x4 w; w.x = pk2(a[0], a[1]); w.y = pk2(a[2], a[3]); w.z = pk2(b[0], b[1]); w.w = pk2(b[2], b[3]); return w; }
DI void unpack8(const u32x4& w, float (&f)[8]) { f[0] = bflo(w.x); f[1] = bfhi(w.x); f[2] = bflo(w.y); f[3] = bfhi(w.y); f[4] = bflo(w.z); f[5] = bfhi(w.z); f[6] = bflo(w.w); f[7] = bfhi(w.w); }


#define XB_TMO      128
#define XB_XCNT(j)  (256  + 64 * (j))
#define XB_XSUB(j)  (1280 + 64 * (j))
#define XB_XGEN(j)  (2304 + 64 * (j))
#define XB_TOP      3328
#define XB_TOPGEN   3392
#define XCD_BAR_WORDS 3456
#define XB_SPIN_CAP (1u << 18)
DI unsigned xb_ld(unsigned* p)              { return __hip_atomic_load(p, __ATOMIC_RELAXED, __HIP_MEMORY_SCOPE_AGENT); }
DI unsigned xb_add(unsigned* p, unsigned v) { return __hip_atomic_fetch_add(p, v, __ATOMIC_RELAXED, __HIP_MEMORY_SCOPE_AGENT); }
DI unsigned xb_xcc_id() { return (unsigned)__builtin_amdgcn_s_getreg((3 << 11) | 20) & 0xFu; }
#define XB_SPIN(cond, bar) do { unsigned _sp = 0; while (cond) { __builtin_amdgcn_s_sleep(1); \
    if ((++_sp & 255u) == 0u) { if (xb_ld(&(bar)[XB_TMO])) break; if (_sp > XB_SPIN_CAP) { atomicAdd(&(bar)[XB_TMO], 1u); break; } } } } while (0)
struct XcdBarrier { unsigned* bar; unsigned x; volatile LAS unsigned* st; };
DI XcdBarrier xcd_barrier_post(unsigned* bar, volatile LAS unsigned* st) {
    XcdBarrier b; b.bar = bar; b.x = xb_xcc_id(); b.st = st;
    if (threadIdx.x == 0) (void)xb_add(&bar[XB_XCNT(b.x)], 1u);
    return b;
}
DI void xcd_barrier_complete(unsigned* bar, unsigned x, unsigned& nloc, unsigned& nx) {
    const unsigned G = gridDim.x * gridDim.y * gridDim.z;
    unsigned sum, cnt, mine, sp = 0u;
    for (;;) {
        sum = 0u; cnt = 0u; mine = 0u;
#pragma unroll
        for (unsigned j = 0; j < 16; ++j) { const unsigned c = xb_ld(&bar[XB_XCNT(j)]); sum += c; cnt += (c > 0u) ? 1u : 0u; mine = (j == x) ? c : mine; }
        if (sum == G) break;
        __builtin_amdgcn_s_sleep(1);
        if ((++sp & 255u) == 0u) { if (xb_ld(&bar[XB_TMO])) break; if (sp > XB_SPIN_CAP) { atomicAdd(&bar[XB_TMO], 1u); break; } }
    }
    nloc = mine > 0u ? mine : 1u; nx = cnt > 0u ? cnt : 1u;
}
DI void xcd_barrier(const XcdBarrier& b) {
    asm volatile("s_waitcnt vmcnt(0)" ::: "memory");
    __syncthreads();
    if (threadIdx.x == 0) {
        unsigned* bar = b.bar;
        __builtin_amdgcn_s_waitcnt(0);
        unsigned nloc = b.st[0], nx = b.st[1];
        if (nloc == 0u) { xcd_barrier_complete(bar, b.x, nloc, nx); b.st[0] = nloc; b.st[1] = nx; }
        const unsigned old = xb_add(&bar[XB_XSUB(b.x)], 1u);
        const unsigned gen = old / nloc;
        if (old + 1u == (gen + 1u) * nloc) {
            __builtin_amdgcn_fence(__ATOMIC_RELEASE, "agent");
            asm volatile("s_waitcnt vmcnt(0)" ::: "memory");
            const unsigned og = xb_add(&bar[XB_TOP], 1u);
            const unsigned tg = og / nx;
            if (og + 1u == (tg + 1u) * nx) xb_add(&bar[XB_TOPGEN], 1u);
            else XB_SPIN(xb_ld(&bar[XB_TOPGEN]) == tg, bar);
            __builtin_amdgcn_fence(__ATOMIC_ACQUIRE, "agent");
            xb_add(&bar[XB_XGEN(b.x)], 1u);
            asm volatile("s_waitcnt vmcnt(0)" ::: "memory");
        } else {
            XB_SPIN(xb_ld(&bar[XB_XGEN(b.x)]) == gen, bar);
            __builtin_amdgcn_fence(__ATOMIC_ACQUIRE, "agent");
            asm volatile("s_waitcnt vmcnt(0)" ::: "memory");
        }
    }
    __syncthreads();
}

namespace pg8 {
constexpr int BM = 256, BK = 64, HALF = 128, HTB = HALF * BK * 2, STAGE_BYTES = 8 * HTB, NXCD = 8, WGM = 8;
DI int lds_byte(int r, int c) { const int st = (r >> 4) * 2 + (c >> 5), rr = r & 15, cc = c & 31, ob = rr * 64 + cc * 2; return st * 1024 + (ob ^ (((ob >> 9) & 1) << 5)); }
DI void stage_rc(int b, int& R, int& C) { const int st = b / 1024, sb = b % 1024, swz = sb ^ (((sb >> 9) & 1) << 5); R = (st >> 1) * 16 + swz / 64; C = (st & 1) * 32 + (swz % 64) / 2; }
DI int perm32(int rho) { const int n = rho >> 4, i = rho & 15; return 8 * (i >> 2) + 4 * n + (i & 3); }

struct Unit { int pm, pn, part; };
struct Order {
    int nM, nN, nwg, G, c, parts, K;
    const bf16_t *A0, *A1, *B0, *B1;
    DI void init(int nM_, int nN_, int G_, int c_, int K_, const bf16_t* a0, const bf16_t* b0, int parts_ = 1, const bf16_t* a1 = nullptr, const bf16_t* b1 = nullptr) {
        nM = nM_; nN = nN_; nwg = nM * nN; G = G_; c = c_; K = K_; parts = parts_; A0 = a0; B0 = b0; A1 = a1; B1 = b1; }
    DI bool next(int i, Unit& u) const {
        const int ti = (parts == 2) ? (i >> 1) : i; u.part = (parts == 2) ? (i & 1) : 0;
        const long L = (long)ti * G + c; if (L >= nwg) return false;
        int wgid = (int)L; { const int q = nwg / NXCD, r = nwg % NXCD, xcd = wgid % NXCD, off = wgid / NXCD; wgid = (xcd < r ? xcd * (q + 1) : r * (q + 1) + (xcd - r) * q) + off; }
        const int nig = WGM * nN, gid = wgid / nig, fm = gid * WGM, gsz = (nM - fm) < WGM ? (nM - fm) : WGM;
        u.pm = fm + ((wgid % nig) % gsz); u.pn = (wgid % nig) / gsz; return true;
    }
    DI const char* pa(const Unit& u) const { return (const char*)(u.part ? A1 : A0) + (size_t)u.pm * BM * K * 2; }
    DI const char* pb(const Unit& u) const { return (const char*)(u.part ? B1 : B0) + (size_t)u.pn * BM * K * 2; }
};

template <class Epi>
__device__ __forceinline__ void gemm_phase(LAS unsigned char* lds, const Order& S, const Epi& E) {
    const int tid = threadIdx.x, wid = __builtin_amdgcn_readfirstlane(tid >> 6), lane = tid & 63, wr = wid >> 2, wc = wid & 3, fr = lane & 15, fq = lane >> 4;
    const int K = S.K, nt = K / BK;
    unsigned voffA[2], voffB[2];
#pragma unroll
    for (int i = 0; i < 2; ++i) { int R, C; stage_rc(tid * 16 + i * 8192, R, C); const int Rb = (R & ~31) + perm32(R & 31);
        voffA[i] = (unsigned)(R * K + C) * 2u; voffB[i] = (unsigned)(Rb * K + C) * 2u; }
    const size_t kstep = (size_t)(BK * 2);
    const size_t hstep = (size_t)HALF * K * 2;
    const unsigned ldsw = (unsigned)wid * 1024u;
    const int aoff = lds_byte(wr * 64 + fr, fq * 8), boff = lds_byte(wc * 32 + fr, fq * 8);
#define PG8_SA(b, h) (((b) * 2 + (h)) * HTB)
#define PG8_SB(b, h) ((4 + (b) * 2 + (h)) * HTB)
#define PG8_STAGE(bufoff, gbase, voff) do { _Pragma("unroll") for (int _i = 0; _i < 2; ++_i) \
        __builtin_amdgcn_global_load_lds((const unsigned*)((const char*)(gbase) + (voff)[_i]), (LAS unsigned*)(lds + (bufoff) + ldsw + _i * 8192), 16, 0, 0); } while (0)
#define PG8_LDA(dst, b, h) do { _Pragma("unroll") for (int m = 0; m < 4; ++m) _Pragma("unroll") for (int k = 0; k < 2; ++k) dst[m][k] = *(const LAS bf16x8*)(lds + PG8_SA(b, h) + aoff + m * 2048 + k * 1024); } while (0)
#define PG8_LDB(dst, b, h) do { _Pragma("unroll") for (int n = 0; n < 2; ++n) _Pragma("unroll") for (int k = 0; k < 2; ++k) dst[n][k] = *(const LAS bf16x8*)(lds + PG8_SB(b, h) + boff + n * 2048 + k * 1024); } while (0)
#define PG8_MMA(ai, bj, At, Bt) do { __builtin_amdgcn_s_setprio(1); _Pragma("unroll") for (int m = 0; m < 4; ++m) _Pragma("unroll") for (int n = 0; n < 2; ++n) _Pragma("unroll") for (int k = 0; k < 2; ++k) \
        acc[ai][bj][m][n] = __builtin_amdgcn_mfma_f32_16x16x32_bf16(Bt[n][k], At[m][k], acc[ai][bj][m][n], 0, 0, 0); __builtin_amdgcn_s_setprio(0); } while (0)
#define PG8_WAIT_V(n) asm volatile("s_waitcnt vmcnt(" #n ")" ::: "memory")
#define PG8_WAIT_L(n) asm volatile("s_waitcnt lgkmcnt(" #n ")" ::: "memory")
#define PG8_BAR __builtin_amdgcn_s_barrier()
#define PG8_SCHED __builtin_amdgcn_sched_barrier(0)
    Unit cur, nxt; int ui = 0;
    if (!S.next(0, cur)) return;
    f32x4 acc[2][2][4][2];
#pragma unroll
    for (int a = 0; a < 2; ++a)
#pragma unroll
        for (int b = 0; b < 2; ++b)
#pragma unroll
            for (int m = 0; m < 4; ++m)
#pragma unroll
                for (int n = 0; n < 2; ++n) acc[a][b][m][n] = (f32x4){0.f, 0.f, 0.f, 0.f};
    bf16x8 At[4][2], B0[2][2], B1[2][2];
    const char* cA = S.pa(cur); const char* cB = S.pb(cur);
    PG8_STAGE(PG8_SB(0, 0), cB, voffB); PG8_STAGE(PG8_SA(0, 0), cA, voffA); PG8_STAGE(PG8_SB(0, 1), cB + hstep, voffB); PG8_STAGE(PG8_SA(0, 1), cA + hstep, voffA);
    if (wr == 1) PG8_BAR;
    PG8_WAIT_V(4); PG8_BAR;
    PG8_STAGE(PG8_SB(1, 0), cB + kstep, voffB); PG8_STAGE(PG8_SA(1, 0), cA + kstep, voffA); PG8_STAGE(PG8_SB(1, 1), cB + hstep + kstep, voffB);
    PG8_WAIT_V(6); PG8_BAR;
    for (;;) {
        const bool has_next = S.next(ui + 1, nxt);
        const char* nA = has_next ? S.pa(nxt) : cA; const char* nB = has_next ? S.pb(nxt) : cB;
        for (int t = 0; t < nt; t += 2) {
            const bool last = (t == nt - 2);
            const char* a1 = cA + (size_t)(t + 1) * kstep;
            const char* a2 = last ? nA : cA + (size_t)(t + 2) * kstep; const char* b2 = last ? nB : cB + (size_t)(t + 2) * kstep;
            const char* a3 = a2 + kstep; const char* b3 = b2 + kstep;
            PG8_LDB(B0, 0, 0); PG8_SCHED; PG8_LDA(At, 0, 0); PG8_STAGE(PG8_SA(1, 1), a1 + hstep, voffA);
            PG8_WAIT_L(8); PG8_BAR; PG8_WAIT_L(0); PG8_MMA(0, 0, At, B0); PG8_BAR; PG8_SCHED;
            PG8_LDB(B1, 0, 1); PG8_STAGE(PG8_SB(0, 0), b2, voffB);
            PG8_BAR; PG8_WAIT_L(0); PG8_MMA(0, 1, At, B1); PG8_BAR;
            PG8_LDA(At, 0, 1); PG8_STAGE(PG8_SA(0, 0), a2, voffA);
            PG8_BAR; PG8_WAIT_L(0); PG8_MMA(1, 0, At, B0); PG8_BAR; PG8_SCHED;
            PG8_STAGE(PG8_SB(0, 1), b2 + hstep, voffB);
            PG8_WAIT_V(6); PG8_BAR; PG8_MMA(1, 1, At, B1); PG8_BAR;
            PG8_LDB(B0, 1, 0); PG8_SCHED; PG8_LDA(At, 1, 0); PG8_STAGE(PG8_SA(0, 1), a2 + hstep, voffA);
            PG8_WAIT_L(8); PG8_BAR; PG8_WAIT_L(0); PG8_MMA(0, 0, At, B0); PG8_BAR; PG8_SCHED;
            PG8_LDB(B1, 1, 1); PG8_STAGE(PG8_SB(1, 0), b3, voffB);
            PG8_BAR; PG8_WAIT_L(0); PG8_MMA(0, 1, At, B1); PG8_BAR;
            PG8_LDA(At, 1, 1); PG8_STAGE(PG8_SA(1, 0), a3, voffA);
            PG8_BAR; PG8_WAIT_L(0); PG8_MMA(1, 0, At, B0); PG8_BAR; PG8_SCHED;
            PG8_STAGE(PG8_SB(1, 1), b3 + hstep, voffB);
            PG8_WAIT_V(6); PG8_BAR; PG8_MMA(1, 1, At, B1); PG8_BAR;
        }
        E(acc, cur, wr, wc, fr, fq);
        if (!has_next) break;
        if (!E.keep(cur)) {
#pragma unroll
            for (int a = 0; a < 2; ++a)
#pragma unroll
                for (int b = 0; b < 2; ++b)
#pragma unroll
                    for (int m = 0; m < 4; ++m)
#pragma unroll
                        for (int n = 0; n < 2; ++n) acc[a][b][m][n] = (f32x4){0.f, 0.f, 0.f, 0.f};
        }
        cur = nxt; cA = nA; cB = nB; ++ui;
    }
    PG8_WAIT_V(0);
    if (wr == 0) PG8_BAR;
    PG8_BAR;
#undef PG8_SA
#undef PG8_SB
#undef PG8_STAGE
#undef PG8_LDA
#undef PG8_LDB
#undef PG8_MMA
#undef PG8_WAIT_V
#undef PG8_WAIT_L
#undef PG8_BAR
#undef PG8_SCHED
}

typedef f32x4 Acc[2][2][4][2];
struct EpiProjH {
    bf16_t* seg; const float* lbl;
    DI bool keep(const Unit&) const { return false; }
    DI void operator()(Acc& acc, const Unit& u, int wr, int wc, int fr, int fq) const {
        const int colt = u.pn * BM, sg = colt >> 10, cb = (colt & 1023) + wc * 32 + 8 * fq;
        bf16_t* base = seg + (size_t)sg * MT * 1024;
#pragma unroll
        for (int bj = 0; bj < 2; ++bj) {
            const int c0 = cb + bj * HALF;
            float lb[8];
            if (sg == 1) {
#pragma unroll
                for (int j = 0; j < 8; ++j) lb[j] = sigm(lbl[c0 + j] - lbl[1024 + c0 + j]);
            }
#pragma unroll
            for (int ai = 0; ai < 2; ++ai)
#pragma unroll
                for (int m = 0; m < 4; ++m) {
                    const int row = u.pm * BM + wr * 64 + fr + ai * HALF + m * 16;
                    float v[8];
#pragma unroll
                    for (int j = 0; j < 4; ++j) { v[j] = acc[ai][bj][m][0][j]; v[4 + j] = acc[ai][bj][m][1][j]; }
                    if (sg == 0 || sg == 3) {
#pragma unroll
                        for (int j = 0; j < 8; ++j) v[j] = silu(v[j]);
                    } else if (sg == 1) {
#pragma unroll
                        for (int j = 0; j < 8; ++j) v[j] = __log2f(lb[j] + (1.0f - lb[j]) * sigm(v[j]));
                    }
                    u32x4 w; w.x = pk2(v[0], v[1]); w.y = pk2(v[2], v[3]); w.z = pk2(v[4], v[5]); w.w = pk2(v[6], v[7]);
                    *(u32x4*)(base + (size_t)row * 1024 + c0) = w;
                }
        }
    }
};
struct EpiProjL {
    bf16_t* seg; float* out;
    DI bool keep(const Unit&) const { return false; }
    DI void operator()(Acc& acc, const Unit& u, int wr, int wc, int fr, int fq) const {
        const int colt = u.pn * BM, sg = colt >> 10, cb = (colt & 1023) + wc * 32 + 8 * fq;
        bf16_t* base = seg + (size_t)sg * MT * 1024;
#pragma unroll
        for (int bj = 0; bj < 2; ++bj) {
            const int c0 = cb + bj * HALF;
#pragma unroll
            for (int ai = 0; ai < 2; ++ai)
#pragma unroll
                for (int m = 0; m < 4; ++m) {
                    const int row = u.pm * BM + wr * 64 + fr + ai * HALF + m * 16;
                    float v[8];
#pragma unroll
                    for (int j = 0; j < 4; ++j) { v[j] = acc[ai][bj][m][0][j]; v[4 + j] = acc[ai][bj][m][1][j]; }
                    if (sg == 0) {
                        float* dst = nullptr;
                        if (row < MP) { const int t = row & (TSEQ - 1); if (t >= TSEQ - 3) dst = out + O_CVP + ((size_t)(row >> 11) * 3 + (t - (TSEQ - 3))) * 1024 + c0; }
                        else if (row < MR) dst = out + O_CVS + ((size_t)(row - MP) * 3 + 2) * 1024 + c0;
                        if (dst) { *(f32x4*)dst = acc[ai][bj][m][0]; *(f32x4*)(dst + 4) = acc[ai][bj][m][1]; }
                    } else if (sg == 1) {
#pragma unroll
                        for (int j = 0; j < 8; ++j) v[j] = gelu_tanh(v[j]);
                    } else {
#pragma unroll
                        for (int j = 0; j < 8; ++j) v[j] = sigm(v[j]);
                    }
                    u32x4 w; w.x = pk2(v[0], v[1]); w.y = pk2(v[2], v[3]); w.z = pk2(v[4], v[5]); w.w = pk2(v[6], v[7]);
                    *(u32x4*)(base + (size_t)row * 1024 + c0) = w;
                }
        }
    }
};
struct EpiMerge {
    const bf16_t *sga, *sgb; bf16_t* dst;
    DI bool keep(const Unit& u) const { return u.part == 0; }
    DI void operator()(Acc& acc, const Unit& u, int wr, int wc, int fr, int fq) const {
#pragma unroll
        for (int bj = 0; bj < 2; ++bj) {
            const int c0 = u.pn * BM + wc * 32 + 8 * fq + bj * HALF;
#pragma unroll
            for (int ai = 0; ai < 2; ++ai)
#pragma unroll
                for (int m = 0; m < 4; ++m) {
                    const int row = u.pm * BM + wr * 64 + fr + ai * HALF + m * 16;
                    const size_t off = (size_t)row * 1024 + c0;
                    float gb[8]; unpack8(*(const u32x4*)(sgb + off), gb);
                    if (u.part == 0) {
                        float ga[8]; unpack8(*(const u32x4*)(sga + off), ga);
#pragma unroll
                        for (int j = 0; j < 4; ++j) { acc[ai][bj][m][0][j] *= ga[j] * frcp(gb[j]); acc[ai][bj][m][1][j] *= ga[4 + j] * frcp(gb[4 + j]); }
                    } else {
                        float v[8];
#pragma unroll
                        for (int j = 0; j < 4; ++j) { v[j] = acc[ai][bj][m][0][j] * gb[j]; v[4 + j] = acc[ai][bj][m][1][j] * gb[4 + j]; }
                        u32x4 w; w.x = pk2(v[0], v[1]); w.y = pk2(v[2], v[3]); w.z = pk2(v[4], v[5]); w.w = pk2(v[6], v[7]);
                        *(u32x4*)(dst + off) = w;
                    }
                }
        }
    }
};
struct EpiF32 {
    float* C;
    DI bool keep(const Unit&) const { return false; }
    DI void operator()(Acc& acc, const Unit& u, int wr, int wc, int fr, int fq) const {
#pragma unroll
        for (int bj = 0; bj < 2; ++bj) {
            const int c0 = u.pn * BM + wc * 32 + 8 * fq + bj * HALF;
#pragma unroll
            for (int ai = 0; ai < 2; ++ai)
#pragma unroll
                for (int m = 0; m < 4; ++m) {
                    const int row = u.pm * BM + wr * 64 + fr + ai * HALF + m * 16;
                    float* p = C + (size_t)row * 1024 + c0;
                    *(f32x4*)p = acc[ai][bj][m][0]; *(f32x4*)(p + 4) = acc[ai][bj][m][1];
                }
        }
    }
};
struct EpiSwiGLU {
    bf16_t* act;
    DI bool keep(const Unit&) const { return false; }
    DI void operator()(Acc& acc, const Unit& u, int wr, int wc, int fr, int fq) const {
        const int c0 = u.pn * HALF + wc * 32 + 8 * fq;
#pragma unroll
        for (int ai = 0; ai < 2; ++ai)
#pragma unroll
            for (int m = 0; m < 4; ++m) {
                const int row = u.pm * BM + wr * 64 + fr + ai * HALF + m * 16;
                float v[8];
#pragma unroll
                for (int j = 0; j < 4; ++j) { v[j] = silu(acc[ai][0][m][0][j]) * acc[ai][1][m][0][j]; v[4 + j] = silu(acc[ai][0][m][1][j]) * acc[ai][1][m][1][j]; }
                u32x4 w; w.x = pk2(v[0], v[1]); w.y = pk2(v[2], v[3]); w.z = pk2(v[4], v[5]); w.w = pk2(v[6], v[7]);
                *(u32x4*)(act + (size_t)row * DFF + c0) = w;
            }
    }
};
}


constexpr int RED_STRIDE = 68, RED_WAVE = 16 * RED_STRIDE, RED_BYTES = 8 * RED_WAVE * 4;
template <int NT>
DI void skinny_core(const bf16_t* A, int lda, const bf16_t* const (&B)[NT], int ldb, int K, LAS float* RED) {
    const int tid = threadIdx.x, lane = tid & 63, w = tid >> 6, fr = lane & 15, fg = lane >> 4;
    f32x4 acc[NT];
#pragma unroll
    for (int nt = 0; nt < NT; ++nt) acc[nt] = (f32x4){0.f, 0.f, 0.f, 0.f};
    const int nper = K >> 8;
    const bf16_t* ap = A + (size_t)fr * lda + 8 * fg + 32 * w;
    const bf16_t* bp[NT];
#pragma unroll
    for (int nt = 0; nt < NT; ++nt) bp[nt] = B[nt] + (size_t)fr * ldb + 8 * fg + 32 * w;
    for (int i0 = 0; i0 < nper; i0 += 4) {
        bf16x8 a[4], b[4][NT];
#pragma unroll
        for (int u = 0; u < 4; ++u) if (i0 + u < nper) {
            a[u] = *(const bf16x8*)(ap + (size_t)(i0 + u) * 256);
#pragma unroll
            for (int nt = 0; nt < NT; ++nt) b[u][nt] = *(const bf16x8*)(bp[nt] + (size_t)(i0 + u) * 256);
        }
#pragma unroll
        for (int u = 0; u < 4; ++u) if (i0 + u < nper) {
#pragma unroll
            for (int nt = 0; nt < NT; ++nt) acc[nt] = __builtin_amdgcn_mfma_f32_16x16x32_bf16(a[u], b[u][nt], acc[nt], 0, 0, 0);
        }
    }
#pragma unroll
    for (int nt = 0; nt < NT; ++nt)
#pragma unroll
        for (int j = 0; j < 4; ++j) RED[w * RED_WAVE + (4 * fg + j) * RED_STRIDE + 16 * nt + fr] = acc[nt][j];
}
DI void skinny_reduce(const LAS float* RED, int row, int col0, float (&v)[8]) {
#pragma unroll
    for (int j = 0; j < 8; ++j) v[j] = 0.f;
#pragma unroll
    for (int w = 0; w < 8; ++w) {
        const f32x4 a = *(const LAS f32x4*)(RED + w * RED_WAVE + row * RED_STRIDE + col0), b = *(const LAS f32x4*)(RED + w * RED_WAVE + row * RED_STRIDE + col0 + 4);
        v[0] += a.x; v[1] += a.y; v[2] += a.z; v[3] += a.w; v[4] += b.x; v[5] += b.y; v[6] += b.z; v[7] += b.w;
    }
}
DI void store8_bf16(bf16_t* dst, const float (&v)[8]) { *(u32x4*)dst = (u32x4){pk2(v[0], v[1]), pk2(v[2], v[3]), pk2(v[4], v[5]), pk2(v[6], v[7])}; }

DI void skinny_proj(const Params& p, LAS unsigned char* lds, int half) {
    LAS float* RED = (LAS float*)lds;
    const bf16_t* XN = (const bf16_t*)p.out + (size_t)MP * 1024;
    const bf16_t* WT = (const bf16_t*)(p.ws + WS_WIN) + (size_t)half * 4096 * 1024;
    bf16_t* SEG = (bf16_t*)(p.ws + WS_SEG);
    const int tid = threadIdx.x;
    for (int u = blockIdx.x; u < 512; u += gridDim.x) {
        const int rt = u & 7, ct = u >> 3;
        const bf16_t* B[4] = {WT + (size_t)(64 * ct) * 1024, WT + (size_t)(64 * ct + 16) * 1024, WT + (size_t)(64 * ct + 32) * 1024, WT + (size_t)(64 * ct + 48) * 1024};
        skinny_core<4>(XN + (size_t)(16 * rt) * 1024, 1024, B, 1024, 1024, RED);
        __syncthreads();
        if (tid < 128) {
            const int r = tid >> 3, c8 = tid & 7, bs = 16 * rt + r, row = MP + bs, col = 64 * ct + 8 * c8, sg = col >> 10, cc = col & 1023;
            float v[8]; skinny_reduce(RED, r, 8 * c8, v);
            if (half == 0) {
                if (sg == 0 || sg == 3) {
#pragma unroll
                    for (int j = 0; j < 8; ++j) v[j] = silu(v[j]);
                } else if (sg == 1) {
#pragma unroll
                    for (int j = 0; j < 8; ++j) { const float lb = sigm(p.in[10][cc + j] - p.in[10][1024 + cc + j]); v[j] = __log2f(lb + (1.0f - lb) * sigm(v[j])); }
                }
            } else {
                if (sg == 0) { float* dst = p.out + O_CVS + ((size_t)bs * 3 + 2) * 1024 + cc; *(f32x4*)dst = (f32x4){v[0], v[1], v[2], v[3]}; *(f32x4*)(dst + 4) = (f32x4){v[4], v[5], v[6], v[7]}; }
                else if (sg == 1) {
#pragma unroll
                    for (int j = 0; j < 8; ++j) v[j] = gelu_tanh(v[j]);
                } else {
#pragma unroll
                    for (int j = 0; j < 8; ++j) v[j] = sigm(v[j]);
                }
            }
            store8_bf16(SEG + (size_t)sg * MT * 1024 + (size_t)row * 1024 + cc, v);
        }
        __syncthreads();
    }
}
DI void skinny_merge(const Params& p, LAS unsigned char* lds) {
    LAS float* RED0 = (LAS float*)lds; LAS float* RED1 = (LAS float*)(lds + RED_BYTES);
    bf16_t* SEG = (bf16_t*)(p.ws + WS_SEG);
    const bf16_t* AIN = (const bf16_t*)(p.ws + WS_AIN) + (size_t)MP * 1024; const bf16_t* BIN = (const bf16_t*)(p.ws + WS_BIN) + (size_t)MP * 1024;
    const bf16_t* WA = (const bf16_t*)(p.ws + WS_WPA); const bf16_t* WB = (const bf16_t*)(p.ws + WS_WPB);
    const int tid = threadIdx.x;
    for (int u = blockIdx.x; u < 128; u += gridDim.x) {
        const int rt = u & 7, ct = u >> 3;
        { const bf16_t* B[4] = {WA + (size_t)(64 * ct) * 1024, WA + (size_t)(64 * ct + 16) * 1024, WA + (size_t)(64 * ct + 32) * 1024, WA + (size_t)(64 * ct + 48) * 1024};
          skinny_core<4>(AIN + (size_t)(16 * rt) * 1024, 1024, B, 1024, 1024, RED0); }
        { const bf16_t* B[4] = {WB + (size_t)(64 * ct) * 1024, WB + (size_t)(64 * ct + 16) * 1024, WB + (size_t)(64 * ct + 32) * 1024, WB + (size_t)(64 * ct + 48) * 1024};
          skinny_core<4>(BIN + (size_t)(16 * rt) * 1024, 1024, B, 1024, 1024, RED1); }
        __syncthreads();
        if (tid < 128) {
            const int r = tid >> 3, c8 = tid & 7, row = MP + 16 * rt + r, col = 64 * ct + 8 * c8;
            float va[8], vb[8], ga[8], gb[8]; skinny_reduce(RED0, r, 8 * c8, va); skinny_reduce(RED1, r, 8 * c8, vb);
            const size_t off = (size_t)row * 1024 + col;
            unpack8(*(const u32x4*)(SEG + (size_t)2 * MT * 1024 + off), ga); unpack8(*(const u32x4*)(SEG + (size_t)3 * MT * 1024 + off), gb);
#pragma unroll
            for (int j = 0; j < 8; ++j) va[j] = ga[j] * va[j] + gb[j] * vb[j];
            store8_bf16(SEG + off, va);
        }
        __syncthreads();
    }
}
DI void skinny_f32(LAS unsigned char* lds, const bf16_t* A, int K, const bf16_t* Bt, float* C) {
    LAS float* RED = (LAS float*)lds;
    const int tid = threadIdx.x;
    for (int u = blockIdx.x; u < 128; u += gridDim.x) {
        const int rt = u & 7, ct = u >> 3;
        const bf16_t* B[4] = {Bt + (size_t)(64 * ct) * K, Bt + (size_t)(64 * ct + 16) * K, Bt + (size_t)(64 * ct + 32) * K, Bt + (size_t)(64 * ct + 48) * K};
        skinny_core<4>(A + (size_t)(MP + 16 * rt) * K, K, B, K, K, RED);
        __syncthreads();
        if (tid < 128) {
            const int r = tid >> 3, c8 = tid & 7, row = MP + 16 * rt + r, col = 64 * ct + 8 * c8;
            float v[8]; skinny_reduce(RED, r, 8 * c8, v);
            float* dst = C + (size_t)row * 1024 + col; *(f32x4*)dst = (f32x4){v[0], v[1], v[2], v[3]}; *(f32x4*)(dst + 4) = (f32x4){v[4], v[5], v[6], v[7]};
        }
        __syncthreads();
    }
}
DI void skinny_swiglu(const Params& p, LAS unsigned char* lds) {
    LAS float* RED = (LAS float*)lds;
    bf16_t* SEG = (bf16_t*)(p.ws + WS_SEG);
    const bf16_t* HN = SEG + (size_t)MP * 1024; const bf16_t* WT = (const bf16_t*)(p.ws + WS_WFI); bf16_t* ACT = SEG + (size_t)MT * 1024;
    const int tid = threadIdx.x;
    int u0, ustep;
    if (gridDim.x == 256) { u0 = (int)blockIdx.x - 128; ustep = 128; } else { u0 = blockIdx.x; ustep = gridDim.x; }
    if (u0 < 0) return;
    for (int u = u0; u < 704; u += ustep) {
        const int rt = u & 7, cg = u >> 3, pn = cg >> 2, j0 = 32 * (cg & 3);
        const bf16_t* B[4] = {WT + (size_t)(256 * pn + j0) * 1024, WT + (size_t)(256 * pn + j0 + 16) * 1024, WT + (size_t)(256 * pn + 128 + j0) * 1024, WT + (size_t)(256 * pn + 128 + j0 + 16) * 1024};
        skinny_core<4>(HN + (size_t)(16 * rt) * 1024, 1024, B, 1024, 1024, RED);
        __syncthreads();
        if (tid < 64) {
            const int r = tid >> 2, c8 = tid & 3, row = MP + 16 * rt + r;
            float g[8], up[8]; skinny_reduce(RED, r, 8 * c8, g); skinny_reduce(RED, r, 32 + 8 * c8, up);
#pragma unroll
            for (int j = 0; j < 8; ++j) g[j] = silu(g[j]) * up[j];
            store8_bf16(ACT + (size_t)row * DFF + 128 * pn + j0 + 8 * c8, g);
        }
        __syncthreads();
    }
}

DI void p0_transpose_item(const float* W, int N, int k0, int src_n0, bf16_t* WT, int Kdst, int dst_r0, LAS float* scr, int lane) {
#pragma unroll 8
    for (int i = 0; i < 32; ++i) { const int kk = 2 * i + (lane >> 5); scr[kk * 33 + (lane & 31)] = W[(size_t)(k0 + kk) * N + src_n0 + (lane & 31)]; }
    asm volatile("s_waitcnt lgkmcnt(0)" ::: "memory");
    const int c = lane & 7;
#pragma unroll
    for (int j = 0; j < 4; ++j) { const int n = (lane >> 3) + 8 * j; const LAS float* s = scr + (8 * c) * 33 + n;
        u32x4 o; o.x = pk2(s[0 * 33], s[1 * 33]); o.y = pk2(s[2 * 33], s[3 * 33]); o.z = pk2(s[4 * 33], s[5 * 33]); o.w = pk2(s[6 * 33], s[7 * 33]);
        *(u32x4*)(WT + (size_t)(dst_r0 + n) * Kdst + k0 + 8 * c) = o; }
    asm volatile("s_waitcnt lgkmcnt(0)" ::: "memory");
}
DI const float* xrow_ptr(const Params& p, int row) { return row < MP ? p.in[0] + (size_t)row * DM : p.in[1] + (size_t)(row - MP) * DM; }

DI void phase_prep(const Params& p, LAS unsigned char* lds) {
    const int tid = threadIdx.x, lane = tid & 63, wave = tid >> 6;
    const int gw = blockIdx.x * 8 + wave, NGW = gridDim.x * 8;
    LAS float* scr = (LAS float*)(lds + wave * 16384);
    unsigned char* ws = p.ws;
    constexpr int I_IN = 16 * 256, I_SQ = 16 * 32, I_FI = 16 * 176, I_FO = 44 * 32, I_L = 8 * 8;
    constexpr int NITEMS = I_IN + 3 * I_SQ + I_FI + I_FO + 2 * I_L;
    for (int it = gw; it < NITEMS; it += NGW) {
        int r = it;
        if (r < I_IN) { const int kb = r / 256, nb = r % 256; p0_transpose_item(p.in[9], 8192, 64 * kb, 32 * nb, (bf16_t*)(ws + WS_WIN), 1024, 32 * nb, scr, lane); continue; } r -= I_IN;
        if (r < 3 * I_SQ) { const int w = r / I_SQ, q = r % I_SQ, kb = q / 32, nb = q % 32;
            p0_transpose_item(p.in[w == 0 ? 19 : (w == 1 ? 20 : 21)], 1024, 64 * kb, 32 * nb, (bf16_t*)(ws + (w == 0 ? WS_WPA : (w == 1 ? WS_WPB : WS_WO))), 1024, 32 * nb, scr, lane); continue; } r -= 3 * I_SQ;
        if (r < I_FI) { const int kb = r / 176, nb = r % 176, d0 = 32 * nb, pn = d0 >> 8, h = (d0 >> 7) & 1, j = d0 & 127;
            p0_transpose_item(p.in[22], NFI, 64 * kb, h * DFF + pn * 128 + j, (bf16_t*)(ws + WS_WFI), 1024, d0, scr, lane); continue; } r -= I_FI;
        if (r < I_FO) { const int kb = r / 32, nb = r % 32; p0_transpose_item(p.in[23], 1024, 64 * kb, 32 * nb, (bf16_t*)(ws + WS_WFO), DFF, 32 * nb, scr, lane); continue; } r -= I_FO;
        { const int w = r / I_L, q = r % I_L, blk = q / 8, kb = (q % 8) / 4, nb = q % 4;
          p0_transpose_item(p.in[w == 0 ? 14 : 16] + (size_t)blk * 16384, 128, 64 * kb, 32 * nb, (bf16_t*)(ws + (w == 0 ? WS_WLA : WS_WLX)) + (size_t)blk * 16384, 128, 32 * nb, scr, lane); }
    }
    bf16_t* XN = (bf16_t*)p.out;
    const float* g = p.in[5];
    for (int m = gw; m < MT; m += NGW) {
        u32x2* o = (u32x2*)(XN + (size_t)m * DM) + lane;
        if (m >= MR) {
#pragma unroll
            for (int j = 0; j < 4; ++j) o[64 * j] = (u32x2){0u, 0u};
            continue; }
        const f32x4* xr = (const f32x4*)xrow_ptr(p, m) + lane;
        f32x4 v[4]; float s = 0.f;
#pragma unroll
        for (int j = 0; j < 4; ++j) { v[j] = xr[64 * j]; s += (v[j].x * v[j].x + v[j].y * v[j].y) + (v[j].z * v[j].z + v[j].w * v[j].w); }
        const float rstd = rsqrtf(wave_sum(s) * (1.f / DM) + EPS);
#pragma unroll
        for (int j = 0; j < 4; ++j) { const f32x4 gg = ((const f32x4*)g)[lane + 64 * j];
            o[64 * j] = (u32x2){pk2(v[j].x * rstd * gg.x, v[j].y * rstd * gg.y), pk2(v[j].z * rstd * gg.z, v[j].w * rstd * gg.w)}; }
    }
    for (int i = blockIdx.x * NTHREADS + tid; i < MS * 2 * 1024; i += gridDim.x * NTHREADS) {
        const int b = i / 2048, r = (i / 1024) & 1, c = i & 1023;
        p.out[O_CVS + ((size_t)b * 3 + r) * 1024 + c] = p.in[4][((size_t)b * 3 + r + 1) * 1024 + c];
    }
}

DI void phase_r1(const Params& p, const float* MO, bf16_t* HN) {
    const int tid = threadIdx.x, lane = tid & 63, wave = tid >> 6;
    const int gw = blockIdx.x * 8 + wave, NGW = gridDim.x * 8;
    const float* g1 = p.in[6]; const float* g2 = p.in[7];
    for (int m = gw; m < MR; m += NGW) {
        const f32x4* xr = (const f32x4*)xrow_ptr(p, m) + lane;
        const f32x4* mr = (const f32x4*)(MO + (size_t)m * DM) + lane;
        f32x4 x[4], o[4]; float s = 0.f;
#pragma unroll
        for (int j = 0; j < 4; ++j) { x[j] = xr[64 * j]; o[j] = mr[64 * j]; s += (o[j].x * o[j].x + o[j].y * o[j].y) + (o[j].z * o[j].z + o[j].w * o[j].w); }
        const float r1 = rsqrtf(wave_sum(s) * (1.f / DM) + EPS);
        float s2 = 0.f;
#pragma unroll
        for (int j = 0; j < 4; ++j) { const f32x4 gg = ((const f32x4*)g1)[lane + 64 * j]; x[j] = x[j] + o[j] * r1 * gg; s2 += (x[j].x * x[j].x + x[j].y * x[j].y) + (x[j].z * x[j].z + x[j].w * x[j].w); }
        const float r2 = rsqrtf(wave_sum(s2) * (1.f / DM) + EPS);
        f32x4* yo = (f32x4*)(p.out + O_Y + (size_t)m * DM) + lane;
        u32x2* ho = (u32x2*)(HN + (size_t)m * DM) + lane;
#pragma unroll
        for (int j = 0; j < 4; ++j) { yo[64 * j] = x[j]; const f32x4 gg = ((const f32x4*)g2)[lane + 64 * j];
            ho[64 * j] = (u32x2){pk2(x[j].x * r2 * gg.x, x[j].y * r2 * gg.y), pk2(x[j].z * r2 * gg.z, x[j].w * r2 * gg.w)}; }
    }
}
DI void phase_r2(const Params& p, const float* FO) {
    const int tid = threadIdx.x, lane = tid & 63, wave = tid >> 6;
    const int gw = blockIdx.x * 8 + wave, NGW = gridDim.x * 8;
    const float* g = p.in[8];
    for (int m = gw; m < MR; m += NGW) {
        f32x4* yr = (f32x4*)(p.out + O_Y + (size_t)m * DM) + lane;
        const f32x4* fr = (const f32x4*)(FO + (size_t)m * DM) + lane;
        f32x4 x[4], o[4]; float s = 0.f;
#pragma unroll
        for (int j = 0; j < 4; ++j) { x[j] = yr[64 * j]; o[j] = fr[64 * j]; s += (o[j].x * o[j].x + o[j].y * o[j].y) + (o[j].z * o[j].z + o[j].w * o[j].w); }
        const float r1 = rsqrtf(wave_sum(s) * (1.f / DM) + EPS);
#pragma unroll
        for (int j = 0; j < 4; ++j) { const f32x4 gg = ((const f32x4*)g)[lane + 64 * j]; yr[64 * j] = x[j] + o[j] * r1 * gg; }
    }
}

constexpr int HG_GRAW = 0, HG_BC = 16384, HG_TOT = 49152, HG_DK = 51200, HG_QT = 51712, HG_KT = 69120, HG_KTT = 86528, HG_VT = 104960, HG_PB = 123392, HG_OB = HG_QT, HG_END = 132608;
constexpr int QS = 136, TS = 72, OS = 132;
constexpr int NSEG = 4, TSEG = TSEQ / NSEG, NCH = TSEG / 64;
static_assert(HG_OB + 64 * OS * 4 <= HG_KTT, "OB must fit over QT/KT");

template <int PASS>
DI void hgrn_seg_item(const Params& p, LAS unsigned char* lds, int b, int h, int seg) {
    const int tid0 = threadIdx.x, lane0 = tid0 & 63, w0 = tid0 >> 6, fr0 = lane0 & 15, fg0 = lane0 >> 4;
    const bf16_t* SQ = (const bf16_t*)(p.ws + WS_SEG);
    const bf16_t* SG = SQ + (size_t)MT * 1024; const bf16_t* SV = SG + (size_t)MT * 1024; const bf16_t* SO = SV + (size_t)MT * 1024;
    bf16_t* AIN = (bf16_t*)(p.ws + WS_AIN);
    float* HC = (float*)(p.ws + WS_HC); float* HL = (float*)(p.ws + WS_HL);
    LAS bf16_t* Graw = (LAS bf16_t*)(lds + HG_GRAW); LAS float* BC = (LAS float*)(lds + HG_BC); LAS float* TOT = (LAS float*)(lds + HG_TOT); LAS float* DK = (LAS float*)(lds + HG_DK);
    LAS bf16_t* QT = (LAS bf16_t*)(lds + HG_QT); LAS bf16_t* KT = (LAS bf16_t*)(lds + HG_KT); LAS bf16_t* KTT = (LAS bf16_t*)(lds + HG_KTT);
    LAS bf16_t* VT = (LAS bf16_t*)(lds + HG_VT); LAS bf16_t* PB = (LAS bf16_t*)(lds + HG_PB); LAS float* OB = (LAS float*)(lds + HG_OB);
    const int bh = b * 8 + h;
    f32x4 Sacc[8];
#pragma unroll
    for (int i = 0; i < 8; ++i) Sacc[i] = (f32x4){0.f, 0.f, 0.f, 0.f};
    if (PASS == 2) {
        for (int j = 0; j < seg; ++j) {
            const float* hc = HC + ((size_t)bh * 3 + j) * 16384; const float* hl = HL + ((size_t)bh * 3 + j) * 128;
#pragma unroll
            for (int kt = 0; kt < 8; ++kt)
#pragma unroll
                for (int jj = 0; jj < 4; ++jj) { const int k = 16 * kt + 4 * fg0 + jj; Sacc[kt][jj] = fexp2(hl[k]) * Sacc[kt][jj] + hc[k * 128 + 16 * w0 + fr0]; }
        }
    }
    const size_t rowbase = (size_t)b * TSEQ + (size_t)seg * TSEG;
    const int colh = h * 128;
    float lsum = 0.f;
    u32x4 rq[2], rg[2], rv[2];
    {
        const int as = tid0 >> 3, akg = tid0 & 7, lane = lane0, w = w0;
        const size_t off = (rowbase + as) * 1024 + colh + 16 * akg;
        rg[0] = *(const u32x4*)(SG + off); rg[1] = *(const u32x4*)(SG + off + 8);
        if (PASS == 2) { rq[0] = *(const u32x4*)(SQ + off); rq[1] = *(const u32x4*)(SQ + off + 8); }
        const size_t offv = (rowbase + lane) * 1024 + colh + 16 * w;
        rv[0] = *(const u32x4*)(SV + offv); rv[1] = *(const u32x4*)(SV + offv + 8);
    }
    for (int c = 0; c < NCH; ++c) {
        int tid = threadIdx.x; asm volatile("" : "+v"(tid));
        const int lane = tid & 63, w = tid >> 6, fr = lane & 15, fg = lane >> 4;
        const int as = tid >> 3, akg = tid & 7;
        const int bk = tid & 127, bj = tid >> 7;
        *(LAS u32x4*)(Graw + as * 128 + 16 * akg) = rg[0]; *(LAS u32x4*)(Graw + as * 128 + 16 * akg + 8) = rg[1];
        { const unsigned vw[8] = {rv[0].x, rv[0].y, rv[0].z, rv[0].w, rv[1].x, rv[1].y, rv[1].z, rv[1].w};
#pragma unroll
          for (int i = 0; i < 8; ++i) { VT[(16 * w + 2 * i) * TS + lane] = (bf16_t)(vw[i] & 0xffffu); VT[(16 * w + 2 * i + 1) * TS + lane] = (bf16_t)(vw[i] >> 16); } }
        u32x4 cq[2], go[2];
        if (PASS == 2) { cq[0] = rq[0]; cq[1] = rq[1];
            const size_t offo = (rowbase + (size_t)c * 64 + as) * 1024 + colh + 16 * akg; go[0] = *(const u32x4*)(SO + offo); go[1] = *(const u32x4*)(SO + offo + 8); }
        if (c + 1 < NCH) {
            const size_t off = (rowbase + (size_t)(c + 1) * 64 + as) * 1024 + colh + 16 * akg;
            rg[0] = *(const u32x4*)(SG + off); rg[1] = *(const u32x4*)(SG + off + 8);
            if (PASS == 2) { rq[0] = *(const u32x4*)(SQ + off); rq[1] = *(const u32x4*)(SQ + off + 8); }
            const size_t offv = (rowbase + (size_t)(c + 1) * 64 + lane) * 1024 + colh + 16 * w;
            rv[0] = *(const u32x4*)(SV + offv); rv[1] = *(const u32x4*)(SV + offv + 8);
        }
        __syncthreads();
        float gl[16];
        { float run = 0.f;
#pragma unroll
          for (int i = 0; i < 16; ++i) { gl[i] = bf2f(Graw[(16 * bj + i) * 128 + bk]); run += gl[i]; }
          TOT[bj * 128 + bk] = run; }
        __syncthreads();
        {
            float base = 0.f, total = 0.f;
#pragma unroll
            for (int j = 0; j < 4; ++j) { const float t = TOT[j * 128 + bk]; base += (j < bj) ? t : 0.f; total += t; }
            if (bj == 0) { DK[bk] = fexp2(total); lsum += total; }
            unsigned kw[8];
            float run = base;
#pragma unroll
            for (int i = 0; i < 16; ++i) {
                run += gl[i];
                if (PASS == 2) BC[(16 * bj + i) * 128 + bk] = run;
                gl[i] = fexp2(gl[i]);
            }
            float d = fexp2(total - run);
#pragma unroll
            for (int i = 15; i >= 1; i -= 2) {
                const float kk1 = 1.0f - gl[i], kk0 = 1.0f - gl[i - 1];
                const float d1 = d, d0 = d * gl[i]; d = d0 * gl[i - 1];
                kw[i >> 1] = pk2(kk0 * d0, kk1 * d1);
                if (PASS == 2) { Graw[(16 * bj + i) * 128 + bk] = (bf16_t)f2bf(kk1); Graw[(16 * bj + i - 1) * 128 + bk] = (bf16_t)f2bf(kk0); }
            }
            *(LAS u32x4*)(KTT + bk * TS + 16 * bj) = (u32x4){kw[0], kw[1], kw[2], kw[3]};
            *(LAS u32x4*)(KTT + bk * TS + 16 * bj + 8) = (u32x4){kw[4], kw[5], kw[6], kw[7]};
        }
        __syncthreads();
        f32x4 oacc[4];
        if (PASS == 2) {
            {
                float bc[16];
#pragma unroll
                for (int i = 0; i < 4; ++i) { const f32x4 t = *(const LAS f32x4*)(BC + as * 128 + 16 * akg + 4 * i); bc[4 * i] = t.x; bc[4 * i + 1] = t.y; bc[4 * i + 2] = t.z; bc[4 * i + 3] = t.w; }
                unsigned qw[8], kw[8];
                float qf[16], kf[16];
                unpack8(cq[0], *(float(*)[8])&qf[0]); unpack8(cq[1], *(float(*)[8])&qf[8]);
                { const u32x4 k0v = *(const LAS u32x4*)(Graw + as * 128 + 16 * akg), k1v = *(const LAS u32x4*)(Graw + as * 128 + 16 * akg + 8);
                  unpack8(k0v, *(float(*)[8])&kf[0]); unpack8(k1v, *(float(*)[8])&kf[8]); }
#pragma unroll
                for (int i = 0; i < 16; i += 2) {
                    const float e0 = fexp2(bc[i]), e1 = fexp2(bc[i + 1]);
                    const float n0 = fexp2(fminf(-bc[i], 115.f)), n1 = fexp2(fminf(-bc[i + 1], 115.f));
                    qw[i >> 1] = pk2(qf[i] * e0, qf[i + 1] * e1);
                    kw[i >> 1] = pk2(kf[i] * n0, kf[i + 1] * n1);
                }
                *(LAS u32x4*)(QT + as * QS + 16 * akg) = (u32x4){qw[0], qw[1], qw[2], qw[3]}; *(LAS u32x4*)(QT + as * QS + 16 * akg + 8) = (u32x4){qw[4], qw[5], qw[6], qw[7]};
                *(LAS u32x4*)(KT + as * QS + 16 * akg) = (u32x4){kw[0], kw[1], kw[2], kw[3]}; *(LAS u32x4*)(KT + as * QS + 16 * akg + 8) = (u32x4){kw[4], kw[5], kw[6], kw[7]};
            }
            __syncthreads();
#pragma unroll
            for (int q2 = 0; q2 < 2; ++q2) {
                const int id = 2 * w + q2, ti = id >> 2, si = id & 3;
                f32x4 pacc = (f32x4){0.f, 0.f, 0.f, 0.f};
                if (si <= ti) {
#pragma unroll
                    for (int ks = 0; ks < 4; ++ks) {
                        const bf16x8 a = *(const LAS bf16x8*)(KT + (16 * si + fr) * QS + 32 * ks + 8 * fg);
                        const bf16x8 bq = *(const LAS bf16x8*)(QT + (16 * ti + fr) * QS + 32 * ks + 8 * fg);
                        pacc = __builtin_amdgcn_mfma_f32_16x16x32_bf16(a, bq, pacc, 0, 0, 0);
                    }
                }
                const int t = 16 * ti + fr, s0 = 16 * si + 4 * fg;
                float pv[4];
#pragma unroll
                for (int j = 0; j < 4; ++j) pv[j] = (s0 + j <= t) ? pacc[j] : 0.f;
                *(LAS u32x2*)(PB + t * TS + s0) = (u32x2){pk2(pv[0], pv[1]), pk2(pv[2], pv[3])};
            }
#pragma unroll
            for (int ti = 0; ti < 4; ++ti) oacc[ti] = (f32x4){0.f, 0.f, 0.f, 0.f};
#pragma unroll
            for (int pp = 0; pp < 4; ++pp) {
                const u32x4 sb = pack8(Sacc[2 * pp], Sacc[2 * pp + 1]);
                const bf16x8 bfrag = __builtin_bit_cast(bf16x8, sb);
#pragma unroll
                for (int ti = 0; ti < 4; ++ti) {
                    const u32x2 lo = *(const LAS u32x2*)(QT + (16 * ti + fr) * QS + 32 * pp + 4 * fg);
                    const u32x2 hi = *(const LAS u32x2*)(QT + (16 * ti + fr) * QS + 32 * pp + 16 + 4 * fg);
                    const bf16x8 a = __builtin_bit_cast(bf16x8, (u32x4){lo.x, lo.y, hi.x, hi.y});
                    oacc[ti] = __builtin_amdgcn_mfma_f32_16x16x32_bf16(a, bfrag, oacc[ti], 0, 0, 0);
                }
            }
        }
        bf16x8 vb[2];
#pragma unroll
        for (int ks = 0; ks < 2; ++ks) vb[ks] = *(const LAS bf16x8*)(VT + (16 * w + fr) * TS + 32 * ks + 8 * fg);
#pragma unroll
        for (int kt = 0; kt < 8; ++kt) {
            const f32x4 dsc = *(const LAS f32x4*)(DK + 16 * kt + 4 * fg);
            f32x4 sa = Sacc[kt] * dsc;
#pragma unroll
            for (int ks = 0; ks < 2; ++ks) {
                const bf16x8 a = *(const LAS bf16x8*)(KTT + (16 * kt + fr) * TS + 32 * ks + 8 * fg);
                sa = __builtin_amdgcn_mfma_f32_16x16x32_bf16(a, vb[ks], sa, 0, 0, 0);
            }
            Sacc[kt] = sa;
        }
        if (PASS == 2) {
            __syncthreads();
#pragma unroll
            for (int ti = 0; ti < 4; ++ti) {
#pragma unroll
                for (int ks = 0; ks < 2; ++ks) {
                    if (ks * 32 <= ti * 16 + 15) {
                        const bf16x8 a = *(const LAS bf16x8*)(PB + (16 * ti + fr) * TS + 32 * ks + 8 * fg);
                        oacc[ti] = __builtin_amdgcn_mfma_f32_16x16x32_bf16(a, vb[ks], oacc[ti], 0, 0, 0);
                    }
                }
            }
#pragma unroll
            for (int ti = 0; ti < 4; ++ti)
#pragma unroll
                for (int j = 0; j < 4; ++j) OB[(16 * ti + 4 * fg + j) * OS + 16 * w + fr] = oacc[ti][j];
            __syncthreads();
            {
                float o[16]; float ss = 0.f;
#pragma unroll
                for (int i = 0; i < 4; ++i) { const f32x4 t = *(const LAS f32x4*)(OB + as * OS + 16 * akg + 4 * i); o[4 * i] = t.x; o[4 * i + 1] = t.y; o[4 * i + 2] = t.z; o[4 * i + 3] = t.w; ss += (t.x * t.x + t.y * t.y) + (t.z * t.z + t.w * t.w); }
                ss += __shfl_xor(ss, 1); ss += __shfl_xor(ss, 2); ss += __shfl_xor(ss, 4);
                const float rstd = rsqrtf(ss * (1.f / 128.f) + EPS);
                const size_t off = (rowbase + (size_t)c * 64 + as) * 1024 + colh + 16 * akg;
                float gt[16]; unpack8(go[0], *(float(*)[8])&gt[0]); unpack8(go[1], *(float(*)[8])&gt[8]);
                const float* onw = p.in[11] + 16 * akg;
                unsigned ow[8];
#pragma unroll
                for (int i = 0; i < 16; i += 2) ow[i >> 1] = pk2(o[i] * rstd * onw[i] * gt[i], o[i + 1] * rstd * onw[i + 1] * gt[i + 1]);
                *(u32x4*)(AIN + off) = (u32x4){ow[0], ow[1], ow[2], ow[3]}; *(u32x4*)(AIN + off + 8) = (u32x4){ow[4], ow[5], ow[6], ow[7]};
            }
        }
    }
    if (PASS == 1) {
        float* hc = HC + ((size_t)bh * 3 + seg) * 16384;
#pragma unroll
        for (int kt = 0; kt < 8; ++kt)
#pragma unroll
            for (int j = 0; j < 4; ++j) hc[(16 * kt + 4 * fg0 + j) * 128 + 16 * w0 + fr0] = Sacc[kt][j];
        if (tid0 < 128) HL[((size_t)bh * 3 + seg) * 128 + tid0] = lsum;
    } else if (seg == NSEG - 1) {
        float* so = p.out + O_HGP + (size_t)bh * 16384;
#pragma unroll
        for (int kt = 0; kt < 8; ++kt)
#pragma unroll
            for (int j = 0; j < 4; ++j) so[(16 * kt + 4 * fg0 + j) * 128 + 16 * w0 + fr0] = Sacc[kt][j];
    }
    __syncthreads();
}

DI void hgrn_sample_item(const Params& p, LAS unsigned char* lds, int bs, int h) {
    const int tid = threadIdx.x;
    const bf16_t* SQ = (const bf16_t*)(p.ws + WS_SEG);
    const bf16_t* SG = SQ + (size_t)MT * 1024; const bf16_t* SV = SG + (size_t)MT * 1024; const bf16_t* SO = SV + (size_t)MT * 1024;
    bf16_t* AIN = (bf16_t*)(p.ws + WS_AIN);
    LAS float* RED = (LAS float*)lds;
    LAS float* RSS = (LAS float*)(lds + 8192);
    const size_t roff = (size_t)(MP + bs) * 1024 + h * 128;
    const int v4 = (tid & 31) * 4, kq = tid >> 5;
    const float* S0 = p.in[2] + ((size_t)bs * 8 + h) * 16384;
    float* S1 = p.out + O_HGS + ((size_t)bs * 8 + h) * 16384;
    const u32x2 vw = *(const u32x2*)(SV + roff + v4);
    const f32x4 vv = (f32x4){bflo(vw.x), bfhi(vw.x), bflo(vw.y), bfhi(vw.y)};
    f32x4 op = (f32x4){0.f, 0.f, 0.f, 0.f};
#pragma unroll
    for (int i = 0; i < 8; ++i) {
        const int k = 8 * kq + i;
        const float f = fexp2(bf2f(SG[roff + k])), kk = 1.0f - f, q = bf2f(SQ[roff + k]);
        const f32x4 s0 = *(const f32x4*)(S0 + (size_t)k * 128 + v4);
        const f32x4 sn = s0 * f + vv * kk;
        *(f32x4*)(S1 + (size_t)k * 128 + v4) = sn;
        op += sn * q;
    }
    *(LAS f32x4*)(RED + kq * 128 + v4) = op;
    __syncthreads();
    float o = 0.f;
    if (tid < 128) {
#pragma unroll
        for (int j = 0; j < 16; ++j) o += RED[j * 128 + tid];
        const float ss = wave_sum(o * o);
        if ((tid & 63) == 0) RSS[tid >> 6] = ss;
    }
    __syncthreads();
    if (tid < 128) {
        const float rstd = rsqrtf((RSS[0] + RSS[1]) * (1.f / 128.f) + EPS);
        const float r = o * rstd * p.in[11][tid] * bf2f(SO[roff + tid]);
        AIN[roff + tid] = (bf16_t)f2bf(r);
    }
    __syncthreads();
}

DI void phase_hgrn1(const Params& p, LAS unsigned char* lds) {
    const int c = blockIdx.x, G = gridDim.x;
    if (G == 256) {
        if (c < 192) { const int bh = c / 3, seg = c % 3; hgrn_seg_item<1>(p, lds, bh >> 3, bh & 7, seg);
            for (int i = 0; i < 3; ++i) { const int r = c + 192 * i; hgrn_sample_item(p, lds, r >> 3, r & 7); } }
        else { for (int i = 0; i < 7; ++i) { const int r = 576 + (c - 192) * 7 + i; hgrn_sample_item(p, lds, r >> 3, r & 7); } }
    } else {
        for (int it = c; it < 192 + MS * 8; it += G) {
            if (it < 192) { const int bh = it / 3, seg = it % 3; hgrn_seg_item<1>(p, lds, bh >> 3, bh & 7, seg); }
            else { const int r = it - 192; hgrn_sample_item(p, lds, r >> 3, r & 7); }
        }
    }
}
DI void phase_hgrn2(const Params& p, LAS unsigned char* lds) {
    for (int it = blockIdx.x; it < 256; it += gridDim.x) { const int bh = it >> 2, seg = it & 3; hgrn_seg_item<2>(p, lds, bh >> 3, bh & 7, seg); }
}

constexpr int LR_XC = 0, LR_RA = 69632, LR_IX = 103424, LR_COMP = 137216, LR_END = 141312;
constexpr int XS = 136, RS = 33;
DI float neg_expm1(float x) {
    if (x > -0.1f) { return -x * (1.0f + x * (0.5f + x * (0.16666667f + x * 0.041666668f))); }
    return 1.0f - fexp(x);
}
DI void lru_item(const Params& p, LAS unsigned char* lds, bool sample, int b, int n, int dq) {
    const int tid0 = threadIdx.x, fr0 = tid0 & 15;
    const bf16_t* SLX = (const bf16_t*)(p.ws + WS_SEG); const bf16_t* SLY = SLX + (size_t)MT * 1024;
    bf16_t* BIN = (bf16_t*)(p.ws + WS_BIN);
    LAS bf16_t* XC = (LAS bf16_t*)(lds + LR_XC); LAS float* RA = (LAS float*)(lds + LR_RA); LAS float* IX = (LAS float*)(lds + LR_IX); LAS f32x2* COMP = (LAS f32x2*)(lds + LR_COMP);
    const int ch0 = n * 128;
    const float bias_a0 = p.in[15][ch0 + 32 * dq + fr0], bias_a1 = p.in[15][ch0 + 32 * dq + 16 + fr0];
    const float bias_x0 = p.in[17][ch0 + 32 * dq + fr0], bias_x1 = p.in[17][ch0 + 32 * dq + 16 + fr0];
    const float lam = p.in[18][ch0 + 32 * dq + (tid0 & 31)];
    const float sp8 = 8.0f * (lam > 15.f ? fexp(-lam) : log1pf(fexp(-lam)));
    float hcar = 0.f;
    const int ntiles = sample ? 1 : (TSEQ / 256);
    for (int tile = 0; tile < ntiles; ++tile) {
        const int t0 = tile * 256;
        int tid = threadIdx.x; asm volatile("" : "+v"(tid));
        const int lane = tid & 63, w = tid >> 6, fr = lane & 15, fg = lane >> 4;
        const int c8 = tid & 15, tr = tid >> 4;
        const int sd = tid & 31, sub = tid >> 5, sch = ch0 + 32 * dq + sd;
        {
        float cw[4][8], cbv[8];
#pragma unroll
        for (int j = 0; j < 4; ++j) { const f32x4 w0 = *(const f32x4*)(p.in[12] + j * 1024 + ch0 + 8 * c8), w1 = *(const f32x4*)(p.in[12] + j * 1024 + ch0 + 8 * c8 + 4);
            cw[j][0] = w0.x; cw[j][1] = w0.y; cw[j][2] = w0.z; cw[j][3] = w0.w; cw[j][4] = w1.x; cw[j][5] = w1.y; cw[j][6] = w1.z; cw[j][7] = w1.w; }
        { const f32x4 w0 = *(const f32x4*)(p.in[13] + ch0 + 8 * c8), w1 = *(const f32x4*)(p.in[13] + ch0 + 8 * c8 + 4);
            cbv[0] = w0.x; cbv[1] = w0.y; cbv[2] = w0.z; cbv[3] = w0.w; cbv[4] = w1.x; cbv[5] = w1.y; cbv[6] = w1.z; cbv[7] = w1.w; }
        if (!sample) {
#pragma unroll 1
            for (int hh2 = 0; hh2 < 2; ++hh2) {
                float xin[7][8];
#pragma unroll
                for (int r = 0; r < 7; ++r) {
                    const int t = t0 + 8 * tr + 4 * hh2 - 3 + r;
                    if (t >= 0) unpack8(*(const u32x4*)(SLX + ((size_t)b * TSEQ + t) * 1024 + ch0 + 8 * c8), xin[r]);
                    else {
#pragma unroll
                        for (int i = 0; i < 8; ++i) xin[r][i] = 0.f; }
                }
#pragma unroll
                for (int r = 0; r < 4; ++r) {
                    float y[8];
#pragma unroll
                    for (int i = 0; i < 8; ++i) y[i] = cbv[i] + xin[r][i] * cw[0][i] + xin[r + 1][i] * cw[1][i] + xin[r + 2][i] * cw[2][i] + xin[r + 3][i] * cw[3][i];
                    *(LAS u32x4*)(XC + (8 * tr + 4 * hh2 + r) * XS + 8 * c8) = (u32x4){pk2(y[0], y[1]), pk2(y[2], y[3]), pk2(y[4], y[5]), pk2(y[6], y[7])};
                }
            }
        } else {
#pragma unroll
            for (int r = 0; r < 4; ++r) {
                const int bs = 4 * tr + r;
                float y[8], lx[8];
                unpack8(*(const u32x4*)(SLX + (size_t)(MP + bs) * 1024 + ch0 + 8 * c8), lx);
                const float* cs = p.in[4] + (size_t)bs * 3 * 1024 + ch0 + 8 * c8;
#pragma unroll
                for (int i = 0; i < 8; ++i) y[i] = cbv[i] + cs[i] * cw[0][i] + cs[1024 + i] * cw[1][i] + cs[2048 + i] * cw[2][i] + lx[i] * cw[3][i];
                *(LAS u32x4*)(XC + bs * XS + 8 * c8) = (u32x4){pk2(y[0], y[1]), pk2(y[2], y[3]), pk2(y[4], y[5]), pk2(y[6], y[7])};
            }
        }
        }
        __syncthreads();
        {
        bf16x8 wb[2][2][4];
        {
            const bf16_t* WA = (const bf16_t*)(p.ws + WS_WLA) + (size_t)n * 16384; const bf16_t* WX = (const bf16_t*)(p.ws + WS_WLX) + (size_t)n * 16384;
#pragma unroll
            for (int nt = 0; nt < 2; ++nt)
#pragma unroll
                for (int ks = 0; ks < 4; ++ks) {
                    const int off = (32 * dq + 16 * nt + fr) * 128 + 32 * ks + 8 * fg;
                    wb[0][nt][ks] = *(const bf16x8*)(WA + off); wb[1][nt][ks] = *(const bf16x8*)(WX + off);
                }
        }
#pragma unroll
        for (int tt2 = 0; tt2 < 2; ++tt2) {
            const int tt = 2 * w + tt2;
            if (sample && tt >= 8) break;
            f32x4 acc[2][2];
#pragma unroll
            for (int m = 0; m < 2; ++m)
#pragma unroll
                for (int nt = 0; nt < 2; ++nt) acc[m][nt] = (f32x4){0.f, 0.f, 0.f, 0.f};
#pragma unroll
            for (int ks = 0; ks < 4; ++ks) {
                const bf16x8 a = *(const LAS bf16x8*)(XC + (16 * tt + fr) * XS + 32 * ks + 8 * fg);
#pragma unroll
                for (int m = 0; m < 2; ++m)
#pragma unroll
                    for (int nt = 0; nt < 2; ++nt) acc[m][nt] = __builtin_amdgcn_mfma_f32_16x16x32_bf16(a, wb[m][nt][ks], acc[m][nt], 0, 0, 0);
            }
#pragma unroll
            for (int nt = 0; nt < 2; ++nt)
#pragma unroll
                for (int j = 0; j < 4; ++j) {
                    RA[(16 * tt + 4 * fg + j) * RS + 16 * nt + fr] = acc[0][nt][j] + (nt ? bias_a1 : bias_a0);
                    IX[(16 * tt + 4 * fg + j) * RS + 16 * nt + fr] = acc[1][nt][j] + (nt ? bias_x1 : bias_x0);
                }
        }
        }
        __syncthreads();
        if (!sample) {
            float av[16], bv[16]; float Ap = 1.f, Hl = 0.f;
#pragma unroll
            for (int i = 0; i < 16; ++i) {
                const int tl = 16 * sub + i;
                const float ra = RA[tl * RS + sd], ix = IX[tl * RS + sd], xc = bf2f(XC[tl * XS + 32 * dq + sd]);
                const float la = -sp8 * sigm(ra);
                const float a = fexp(la);
                float mult = sqrtf(neg_expm1(2.0f * la));
                if (t0 + tl == 0) mult = 1.0f;
                const float bb = mult * sigm(ix) * xc;
                av[i] = a; bv[i] = bb; Hl = a * Hl + bb; Ap *= a;
            }
            COMP[sub * 32 + sd] = (f32x2){Ap, Hl};
            __syncthreads();
            float hin = hcar, hall = hcar;
#pragma unroll
            for (int s2 = 0; s2 < 16; ++s2) { const f32x2 cpp = COMP[s2 * 32 + sd]; hall = cpp.x * hall + cpp.y; if (s2 < sub) hin = hall; }
            hcar = hall;
            float hh = hin;
#pragma unroll
            for (int i = 0; i < 16; ++i) {
                hh = av[i] * hh + bv[i];
                const size_t off = ((size_t)b * TSEQ + t0 + 16 * sub + i) * 1024 + sch;
                BIN[off] = (bf16_t)f2bf(bf2f(SLY[off]) * hh);
            }
            if (tile == ntiles - 1 && sub == 15) p.out[O_LRUP + (size_t)b * 1024 + sch] = hh;
        } else {
#pragma unroll
            for (int i = 0; i < 8; ++i) {
                const int bs = 8 * sub + i;
                const float ra = RA[bs * RS + sd], ix = IX[bs * RS + sd], xc = bf2f(XC[bs * XS + 32 * dq + sd]);
                const float la = -sp8 * sigm(ra);
                const float a = fexp(la), mult = sqrtf(neg_expm1(2.0f * la));
                const float hh = a * p.in[3][(size_t)bs * 1024 + sch] + mult * sigm(ix) * xc;
                const size_t off = (size_t)(MP + bs) * 1024 + sch;
                BIN[off] = (bf16_t)f2bf(bf2f(SLY[off]) * hh);
                p.out[O_LRUS + (size_t)bs * 1024 + sch] = hh;
            }
        }
        __syncthreads();
    }
}
DI void phase_lru(const Params& p, LAS unsigned char* lds) {
    const int NI = 256 + 32;
    for (int it = blockIdx.x; it < NI; it += gridDim.x) {
        if (it < 256) lru_item(p, lds, false, it >> 5, (it >> 2) & 7, it & 3);
        else { const int r = it - 256; lru_item(p, lds, true, 0, r >> 2, r & 3); }
    }
}

constexpr int LDS_BYTES = 144 * 1024;
static_assert(HG_END <= LDS_BYTES - 16 && LR_END <= LDS_BYTES - 16 && pg8::STAGE_BYTES <= LDS_BYTES - 16 && 2 * RED_BYTES <= LDS_BYTES - 16, "lds");

__global__ void __launch_bounds__(NTHREADS) fwd_kernel(Params p) {
    extern __shared__ __attribute__((aligned(16))) unsigned char lds_raw[];
    LAS unsigned char* lds = (LAS unsigned char*)lds_raw;
    cg::grid_group grid = cg::this_grid();
    if (p.ph_hi < 0) grid.sync();
    volatile LAS unsigned* bst = (volatile LAS unsigned*)(lds + LDS_BYTES - 16);
    if (threadIdx.x < 4) bst[threadIdx.x] = 0u;
    __syncthreads();
    const XcdBarrier xbar = xcd_barrier_post((unsigned*)(p.ws + WS_BAR), bst);
    const int lo = p.ph_lo, hi = p.ph_hi;
    unsigned char* ws = p.ws;
    bf16_t* SEG = (bf16_t*)(ws + WS_SEG);
    bf16_t* XN = (bf16_t*)p.out;
    const int G = gridDim.x, c = blockIdx.x;
    constexpr int NM = MP / 256;
#ifndef PHMASK
#define PHMASK 0xfff
#endif
#define IN(k) (((PHMASK >> (k)) & 1) && lo <= (k) && (k) < hi)
#define SYNC(k) do { if (IN(k) && IN((k) + 1)) xcd_barrier(xbar); } while (0)
#ifndef DUPMASK
#define DUPMASK 0
#endif
#define DUP(k) (((DUPMASK >> (k)) & 1) ? 2 : 1)
#define RUN(k, ...) do { if (IN(k)) for (int rep = 0; rep < DUP(k); ++rep) { if (rep) xcd_barrier(xbar); __VA_ARGS__ } } while (0)
    RUN(0, phase_prep(p, lds););
    SYNC(0);
    RUN(1, { pg8::Order S; S.init(NM, 16, G, c, 1024, XN, (const bf16_t*)(ws + WS_WIN));
        pg8::EpiProjH E{SEG, p.in[10]}; pg8::gemm_phase(lds, S, E); skinny_proj(p, lds, 0); });
    SYNC(1);
    RUN(2, phase_hgrn1(p, lds););
    SYNC(2);
    RUN(3, phase_hgrn2(p, lds););
    SYNC(3);
    RUN(4, { pg8::Order S; S.init(NM, 16, G, c, 1024, XN, (const bf16_t*)(ws + WS_WIN) + (size_t)4096 * 1024);
        pg8::EpiProjL E{SEG, p.out}; pg8::gemm_phase(lds, S, E); skinny_proj(p, lds, 1); });
    SYNC(4);
    RUN(5, phase_lru(p, lds););
    SYNC(5);
    RUN(6, { pg8::Order S; S.init(NM, 4, G, c, 1024, (const bf16_t*)(ws + WS_AIN), (const bf16_t*)(ws + WS_WPA), 2, (const bf16_t*)(ws + WS_BIN), (const bf16_t*)(ws + WS_WPB));
        pg8::EpiMerge E{SEG + (size_t)2 * MT * 1024, SEG + (size_t)3 * MT * 1024, SEG}; pg8::gemm_phase(lds, S, E); skinny_merge(p, lds); });
    SYNC(6);
    RUN(7, { pg8::Order S; S.init(NM, 4, G, c, 1024, SEG, (const bf16_t*)(ws + WS_WO));
        pg8::EpiF32 E{(float*)(SEG + (size_t)2 * MT * 1024)}; pg8::gemm_phase(lds, S, E); skinny_f32(lds, SEG, 1024, (const bf16_t*)(ws + WS_WO), (float*)(SEG + (size_t)2 * MT * 1024)); });
    SYNC(7);
    RUN(8, phase_r1(p, (const float*)(SEG + (size_t)2 * MT * 1024), SEG););
    SYNC(8);
    RUN(9, { pg8::Order S; S.init(NM, 22, G, c, 1024, SEG, (const bf16_t*)(ws + WS_WFI));
        pg8::EpiSwiGLU E{SEG + (size_t)MT * 1024}; pg8::gemm_phase(lds, S, E); skinny_swiglu(p, lds); });
    SYNC(9);
    RUN(10, { pg8::Order S; S.init(NM, 4, G, c, DFF, SEG + (size_t)MT * 1024, (const bf16_t*)(ws + WS_WFO));
        pg8::EpiF32 E{(float*)(ws + WS_AIN)}; pg8::gemm_phase(lds, S, E); skinny_f32(lds, SEG + (size_t)MT * 1024, DFF, (const bf16_t*)(ws + WS_WFO), (float*)(ws + WS_AIN)); });
    SYNC(10);
    RUN(11, phase_r2(p, (const float*)(ws + WS_AIN)););
#undef RUN
#undef IN
#undef SYNC
}

constexpr int NPHASES = 12;
#ifndef MK_PER_PHASE
#define MK_PER_PHASE 0
#endif

extern "C" void kernel_launch(void* const* d_in, const int* in_sizes, int n_in, void* d_out, int out_size, void* d_ws, size_t ws_size, hipStream_t stream) {
    static int grid = 0;
    if (grid == 0) {
        int dev = 0, cus = 0, per_cu = 0;
        hipGetDevice(&dev);
        hipDeviceGetAttribute(&cus, hipDeviceAttributeMultiprocessorCount, dev);
        hipFuncSetAttribute((const void*)fwd_kernel, hipFuncAttributeMaxDynamicSharedMemorySize, LDS_BYTES);
        hipOccupancyMaxActiveBlocksPerMultiprocessor(&per_cu, (const void*)fwd_kernel, NTHREADS, LDS_BYTES);
        if (per_cu < 1) per_cu = 1;
        grid = cus * per_cu;
        if (ws_size < WS_END) fprintf(stderr, "kernel_launch: workspace too small: %zu < %zu\n", ws_size, (size_t)WS_END);
        fprintf(stderr, "kernel_launch: cus %d per_cu %d grid %d ws %zu\n", cus, per_cu, grid, ws_size);
    }
    Params p{};
    for (int i = 0; i < 24; ++i) p.in[i] = (const float*)d_in[i];
    p.out = (float*)d_out; p.ws = (unsigned char*)d_ws;
#if MK_PER_PHASE
    for (int ph = 0; ph < NPHASES; ++ph) {
        p.ph_lo = ph; p.ph_hi = ph + 1;
        hipLaunchKernelGGL(fwd_kernel, dim3(grid), dim3(NTHREADS), LDS_BYTES, stream, p);
    }
#else
    p.ph_lo = 0; p.ph_hi = NPHASES;
    (void)hipMemsetAsync((unsigned char*)d_ws + WS_BAR, 0, 16384, stream);
    void* args[] = {&p};
    hipError_t e = hipLaunchCooperativeKernel((const void*)fwd_kernel, dim3(grid), dim3(NTHREADS), args, LDS_BYTES, stream);
    if (e != hipSuccess) fprintf(stderr, "cooperative launch failed: %s (grid %d)\n", hipGetErrorString(e), grid);
#endif
}
```
